# Optimizing an MI355X kernel written in HIP

```python
import math
import jax, jax.numpy as jnp
from jax import lax
import numpy as np

D_MODEL = 2048
BATCH = 8
SEQ = 4096
DEPTH = 4

N_MIXERS = 2
N_HEADS = 16
HEAD_DIM = D_MODEL // N_HEADS
D_INNER = N_HEADS * HEAD_DIM
Q_RANK = 512
KV_RANK = 256
IDX_HEADS = 16
IDX_DIM = 64
TOPK_MAX = 256
N_BUCKETS = 32
MAX_DISTANCE = 128
BLOCK_Q = 128
EPS = 1e-6
A_IN = Q_RANK + KV_RANK + IDX_DIM + IDX_HEADS + D_INNER
B_IN = 3 * D_INNER + N_HEADS + D_INNER

kernel_name = "hybrid_dsa_fox_gated_trunk"


def rmsnorm(x, g):
    xf = x.astype(jnp.float32)
    y = xf * lax.rsqrt(jnp.mean(xf * xf, axis=-1, keepdims=True) + EPS)
    return (y * g.astype(jnp.float32)).astype(x.dtype)


def t5_bucket(dist):
    max_exact = N_BUCKETS // 2
    d = jnp.maximum(dist, 0)
    df = jnp.maximum(d, 1).astype(jnp.float32)
    large = max_exact + (jnp.log(df / max_exact) / math.log(MAX_DISTANCE / max_exact)
                         * (N_BUCKETS - max_exact)).astype(jnp.int32)
    large = jnp.minimum(large, N_BUCKETS - 1)
    return jnp.where(d < max_exact, d, large)


def to_blocks(a):
    b, s = a.shape[:2]
    return jnp.swapaxes(a.reshape(b, s // BLOCK_Q, BLOCK_Q, *a.shape[2:]), 0, 1)


def from_blocks(a):
    nb, b, q = a.shape[:3]
    return jnp.swapaxes(a, 0, 1).reshape(b, nb * q, *a.shape[3:])


def dsa_mixer(h, w_in, q_norm, kv_norm, w_q_up, w_uk, w_uv, w_iq, w_out, rel_bias):
    b, s, _ = h.shape
    topk = min(TOPK_MAX, s // 4)
    proj = h @ w_in
    o1 = Q_RANK
    o2 = o1 + KV_RANK
    o3 = o2 + IDX_DIM
    o4 = o3 + IDX_HEADS
    cq = rmsnorm(proj[..., :o1], q_norm)
    c_kv = rmsnorm(proj[..., o1:o2], kv_norm)
    ik = proj[..., o2:o3]
    iw = proj[..., o3:o4] * (IDX_HEADS ** -0.5 * IDX_DIM ** -0.5)
    gate = proj[..., o4:]
    q = (cq @ w_q_up).reshape(b, s, N_HEADS, HEAD_DIM)
    q_abs = jnp.einsum('bshd,rhd->bshr', q, w_uk) * (HEAD_DIM ** -0.5)
    iq = (cq @ w_iq).reshape(b, s, IDX_HEADS, IDX_DIM)
    pos = jnp.arange(s, dtype=jnp.int32)

    def block(args):
        qa, iqb, iwb, tq = args
        dots = jnp.einsum('bthd,bsd->bths', iqb, ik)
        score = jnp.einsum('bths,bth->bts', jax.nn.relu(dots), iwb).astype(jnp.float32)
        causal = pos[None, :] <= tq[:, None]
        score = jnp.where(causal[None], score, -jnp.inf)
        _, idx = lax.top_k(score, topk)
        c_sel = jax.vmap(lambda c, i: c[i])(c_kv, idx)
        dist = tq[None, :, None] - idx
        valid = (dist >= 0)[:, None]
        bias = jnp.moveaxis(rel_bias[t5_bucket(dist)], -1, 1)
        logits = (jnp.einsum('bthr,btkr->bhtk', qa, c_sel).astype(jnp.float32)
                  + bias.astype(jnp.float32))
        logits = jnp.where(valid, logits, -jnp.inf)
        p = jax.nn.softmax(logits, axis=-1).astype(c_sel.dtype)
        return jnp.einsum('bhtk,btkr->bthr', p, c_sel)

    o_lat = from_blocks(lax.map(block, (to_blocks(q_abs), to_blocks(iq), to_blocks(iw),
                                        pos.reshape(-1, BLOCK_Q))))
    o = jnp.einsum('bshr,rhd->bshd', o_lat, w_uv).reshape(b, s, D_INNER)
    return (o * jax.nn.silu(gate)) @ w_out


def fox_mixer(h, w_in, f_bias, w_out):
    b, s, _ = h.shape
    proj = h @ w_in
    q = proj[..., :D_INNER].reshape(b, s, N_HEADS, HEAD_DIM) * (HEAD_DIM ** -0.5)
    k = proj[..., D_INNER:2 * D_INNER].reshape(b, s, N_HEADS, HEAD_DIM)
    v = proj[..., 2 * D_INNER:3 * D_INNER].reshape(b, s, N_HEADS, HEAD_DIM)
    f_pre = proj[..., 3 * D_INNER:3 * D_INNER + N_HEADS]
    gate = proj[..., 3 * D_INNER + N_HEADS:]
    log_f = jax.nn.log_sigmoid((f_pre + f_bias).astype(jnp.float32))
    cum = lax.cumsum(log_f, axis=1)
    cum_keys = jnp.moveaxis(cum, -1, 1)
    pos = jnp.arange(s, dtype=jnp.int32)

    def block(args):
        qb, cb, tq = args
        decay = jnp.moveaxis(cb, -1, 1)[..., None] - cum_keys[:, :, None, :]
        logits = jnp.einsum('bthd,bshd->bhts', qb, k).astype(jnp.float32) + decay
        causal = pos[None, :] <= tq[:, None]
        logits = jnp.where(causal[None, None], logits, -jnp.inf)
        p = jax.nn.softmax(logits, axis=-1).astype(v.dtype)
        return jnp.einsum('bhts,bshd->bthd', p, v)

    o = from_blocks(lax.map(block, (to_blocks(q), to_blocks(cum), pos.reshape(-1, BLOCK_Q))))
    o = o.reshape(b, s, D_INNER)
    return (o * jax.nn.silu(gate)) @ w_out


def setup_inputs(seed: int = 0) -> dict:
    key = jax.random.key(seed)
    ks = jax.random.split(key, 20)
    n_a = (DEPTH + 1) // 2
    n_b = DEPTH // 2
    nrm = lambda k, shape, scale: jax.random.normal(k, shape, jnp.float32) * scale
    return {
        "x": nrm(ks[0], (BATCH, SEQ, D_MODEL), 1.0),
        "norm_g": 1.0 + nrm(ks[1], (DEPTH, D_MODEL), 0.02),
        "final_g": 1.0 + nrm(ks[2], (D_MODEL,), 0.02),
        "rel_bias": nrm(ks[3], (N_BUCKETS, N_HEADS), 0.5),
        "a_w_in": nrm(ks[4], (n_a, D_MODEL, A_IN), D_MODEL ** -0.5),
        "a_q_norm": 1.0 + nrm(ks[5], (n_a, Q_RANK), 0.02),
        "a_kv_norm": 1.0 + nrm(ks[6], (n_a, KV_RANK), 0.02),
        "a_w_q_up": nrm(ks[7], (n_a, Q_RANK, D_INNER), Q_RANK ** -0.5),
        "a_w_uk": nrm(ks[8], (n_a, KV_RANK, N_HEADS, HEAD_DIM), KV_RANK ** -0.5),
        "a_w_uv": nrm(ks[9], (n_a, KV_RANK, N_HEADS, HEAD_DIM), KV_RANK ** -0.5),
        "a_w_iq": nrm(ks[10], (n_a, Q_RANK, IDX_HEADS * IDX_DIM), Q_RANK ** -0.5),
        "a_w_out": nrm(ks[11], (n_a, D_INNER, D_MODEL), D_INNER ** -0.5),
        "b_w_in": nrm(ks[12], (n_b, D_MODEL, B_IN), D_MODEL ** -0.5),
        "b_f_bias": 4.0 + nrm(ks[13], (n_b, N_HEADS), 0.5),
        "b_w_out": nrm(ks[14], (n_b, D_INNER, D_MODEL), D_INNER ** -0.5),
    }


def reference(x, norm_g, final_g, rel_bias, a_w_in, a_q_norm, a_kv_norm, a_w_q_up,
              a_w_uk, a_w_uv, a_w_iq, a_w_out, b_w_in, b_f_bias, b_w_out):
    h = x
    for i in range(DEPTH):
        hn = rmsnorm(h, norm_g[i])
        j = i // N_MIXERS
        if i % N_MIXERS == 0:
            y = dsa_mixer(hn, a_w_in[j], a_q_norm[j], a_kv_norm[j], a_w_q_up[j],
                          a_w_uk[j], a_w_uv[j], a_w_iq[j], a_w_out[j], rel_bias)
        else:
            y = fox_mixer(hn, b_w_in[j], b_f_bias[j], b_w_out[j])
        h = h + y
    return rmsnorm(h, final_g)
```

```cpp
#include <hip/hip_runtime.h>
#include <hip/hip_bf16.h>
#include <cstdio>
#include <cstdint>

#ifndef MK_SPLIT
#define MK_SPLIT 0
#endif

constexpr int BATCH = 8, SEQ = 4096, DM = 2048, NH = 16, HD = 128, DI = 2048, QR = 512, KVR = 256, IDXH = 16, IDXD = 64, TOPK = 256;
constexpr int M = BATCH * SEQ;
constexpr int A_IN = QR + KVR + IDXD + IDXH + DI;
constexpr int B_IN = 3 * DI + NH + DI;
constexpr int NA_IN = 3072;
constexpr int NB_IN = 8448;
constexpr int NQI = 5120;
constexpr float EPS = 1e-6f;

constexpr size_t MiB = 1u << 20;
constexpr size_t WS_CTL = 0, CTL_ZERO_BYTES = 1 * MiB;
constexpr size_t WS_RS = 896 * 1024;
constexpr size_t WS_CMAX = 256 * 1024, WS_CSC = 512 * 1024;
constexpr size_t WS_W = 1 * MiB, W_LAYER = 68 * MiB;
constexpr size_t WO_A_IN = 0, WO_A_Q = 12 * MiB, WO_A_UV = 17 * MiB, WO_A_OUT = 19 * MiB, WO_B_IN = 27 * MiB, WO_B_OUT = 60 * MiB;
constexpr size_t WS_XN = 137 * MiB;
constexpr size_t WS_GATE = 265 * MiB;
constexpr size_t WS_R = 393 * MiB;
constexpr size_t WS_Q = WS_R, WS_K = WS_R + 128 * MiB, WS_V = WS_R + 256 * MiB, WS_LF = WS_R + 384 * MiB, WS_CB = WS_R + 386 * MiB;
constexpr size_t WS_CQRAW = WS_R, WS_CQ = WS_R + 96 * MiB, WS_CKV = WS_R + 128 * MiB, WS_IK = WS_R + 144 * MiB, WS_IW = WS_R + 148 * MiB,
                 WS_IDX = WS_R + 150 * MiB, WS_QI = WS_R + 182 * MiB;
constexpr size_t WS_SS = WS_QI + 320 * MiB;
constexpr size_t WS_H8 = WS_SS + 4 * MiB;
constexpr size_t WS_RMP = WS_H8 + 64 * MiB;
constexpr size_t WS_END = WS_RMP + 4 * MiB;
static_assert((size_t)M * 768 * 4 == 96 * MiB && (size_t)M * NQI * 2 == 320 * MiB && (size_t)NB_IN * 2048 * 2 == 33 * MiB && (size_t)NA_IN * 2048 * 2 == 12 * MiB, "d_ws map");


namespace pg8 {
#define PG8_LAS __attribute__((address_space(3)))
typedef unsigned short bf16_t;
typedef short bf16x8 __attribute__((ext_vector_type(8)));
typedef float f32x4 __attribute__((ext_vector_type(4)));
typedef unsigned u32x4 __attribute__((ext_vector_type(4)));
constexpr int BM = 256, BK = 64, HALF = 128, HTB = HALF * BK * 2  , STAGE_BYTES = 8 * HTB, NXCD = 8, WGM = 4;

__host__ __device__ __forceinline__ int lds_byte(int r, int c) { const int st = (r >> 4) * 2 + (c >> 5), rr = r & 15, cc = c & 31, ob = rr * 64 + cc * 2; return st * 1024 + (ob ^ (((ob >> 9) & 1) << 5)); }
__host__ __device__ __forceinline__ void stage_rc(int b, int& R, int& C) { const int st = b / 1024, sb = b % 1024, swz = sb ^ (((sb >> 9) & 1) << 5); R = (st >> 1) * 16 + swz / 64; C = (st & 1) * 32 + (swz % 64) / 2; }
__host__ __device__ __forceinline__ int perm32(int rho) { const int n = rho >> 4, i = rho & 15; return 8 * (i >> 2) + 4 * n + (i & 3); }

struct Unit { int pm, pn; };
struct Gemm { const bf16_t* A; const bf16_t* Bt; int M, N, K, lda, a_pn_off; };

struct StaticOrder {
    int nM, nN, nwg, G, c;
    __host__ __device__ void init(int M, int N, int G_, int c_) { nM = M / BM; nN = N / BM; nwg = nM * nN; G = G_; c = c_; }
    __host__ __device__ bool next(int i, Unit& u) const {
        const long L = (long)i * G + c; if (L >= nwg) return false;
        int wgid = (int)L; { const int q = nwg / NXCD, r = nwg % NXCD, xcd = wgid % NXCD, off = wgid / NXCD; wgid = (xcd < r ? xcd * (q + 1) : r * (q + 1) + (xcd - r) * q) + off; }
        const int nig = WGM * nN, gid = wgid / nig, fm = gid * WGM, gsz = (nM - fm) < WGM ? (nM - fm) : WGM;
        u.pm = fm + ((wgid % nig) % gsz); u.pn = (wgid % nig) / gsz; return true;
    }
    __device__ __forceinline__ void a_ready(const Unit&) const {}
    __device__ __forceinline__ void done(const Unit&) const {}
};


__device__ __forceinline__ unsigned cvt_pk_bf16(float lo, float hi) { unsigned r; asm volatile("v_cvt_pk_bf16_f32 %0, %1, %2" : "=v"(r) : "v"(lo), "v"(hi)); return r; }
typedef int v8i32 __attribute__((ext_vector_type(8)));
typedef int v4i32 __attribute__((ext_vector_type(4)));
__device__ __forceinline__ v8i32 cat8(const bf16x8 lo, const bf16x8 hi) { const v4i32 a = __builtin_bit_cast(v4i32, lo), b = __builtin_bit_cast(v4i32, hi); return __builtin_shufflevector(a, b, 0, 1, 2, 3, 4, 5, 6, 7); }
struct Frag2 { bf16x8 k[2]; };
template <int OPK> struct FragT;
template <> struct FragT<0> { typedef Frag2 type;
    static __device__ __forceinline__ void load(Frag2& d, const PG8_LAS unsigned char* p) { d.k[0] = *(const PG8_LAS bf16x8*)p; d.k[1] = *(const PG8_LAS bf16x8*)(p + 1024); }
    static __device__ __forceinline__ f32x4 mma(const Frag2& b, const Frag2& a, f32x4 c) { c = __builtin_amdgcn_mfma_f32_16x16x32_bf16(b.k[0], a.k[0], c, 0, 0, 0); return __builtin_amdgcn_mfma_f32_16x16x32_bf16(b.k[1], a.k[1], c, 0, 0, 0); } };
template <> struct FragT<1> { typedef v8i32 type;
    static __device__ __forceinline__ void load(v8i32& d, const PG8_LAS unsigned char* p) { const v4i32 lo = *(const PG8_LAS v4i32*)p, hi = *(const PG8_LAS v4i32*)(p + 1024); d = __builtin_shufflevector(lo, hi, 0, 1, 2, 3, 4, 5, 6, 7); }
    static __device__ __forceinline__ f32x4 mma(const v8i32& b, const v8i32& a, f32x4 c) { return __builtin_amdgcn_mfma_scale_f32_16x16x128_f8f6f4(b, a, c, 0, 0, 0, 0x79797979, 0, 0x7f7f7f7f); } };
__device__ __forceinline__ void epi_lane(int& fr, int& fq) { int l_; asm volatile("v_mbcnt_lo_u32_b32 %0, -1, 0\n\tv_mbcnt_hi_u32_b32 %0, -1, %0" : "=v"(l_)); fr = l_ & 15; fq = l_ >> 4; }
__device__ __forceinline__ float silu_f(float x) { return x * __builtin_amdgcn_rcpf(1.0f + __expf(-x)); }
__device__ __forceinline__ u32x4 pack8_bf16(const f32x4 v0, const f32x4 v1) { u32x4 w; w.x = cvt_pk_bf16(v0[0], v0[1]); w.y = cvt_pk_bf16(v0[2], v0[3]); w.z = cvt_pk_bf16(v1[0], v1[1]); w.w = cvt_pk_bf16(v1[2], v1[3]); return w; }
typedef unsigned u32x2_t __attribute__((ext_vector_type(2)));
__device__ __forceinline__ void st8x2_wide(unsigned char* rowp_self, int fq, u32x2_t A  , u32x2_t B  ) {
    const auto r0 = __builtin_amdgcn_permlane16_swap(A.x, B.x, false, false), r1 = __builtin_amdgcn_permlane16_swap(A.y, B.y, false, false);
    u32x4 w; w.x = r0[0]; w.y = r1[0]; w.z = r0[1]; w.w = r1[1];
    *(u32x4*)(rowp_self + ((fq & 1) ? HALF - 8 : 0)) = w;
}
__device__ __forceinline__ f32x4 silu4(const f32x4 v) { return (f32x4){silu_f(v[0]), silu_f(v[1]), silu_f(v[2]), silu_f(v[3])}; }
__device__ __forceinline__ float bf_lo(unsigned u) { return __uint_as_float(u << 16); }
__device__ __forceinline__ float bf_hi(unsigned u) { return __uint_as_float(u & 0xffff0000u); }

template <> struct FragT<2> { typedef Frag2 type;
    static __device__ __forceinline__ void load(Frag2& d, const PG8_LAS unsigned char* p) { d.k[0] = *(const PG8_LAS bf16x8*)p; d.k[1] = *(const PG8_LAS bf16x8*)(p + 1024); }
    static __device__ __forceinline__ f32x4 mma(const Frag2& b, const Frag2& a, f32x4 c) { v4i32 ci = __builtin_bit_cast(v4i32, c);
        ci = __builtin_amdgcn_mfma_i32_16x16x64_i8(__builtin_bit_cast(v4i32, b.k[0]), __builtin_bit_cast(v4i32, a.k[0]), ci, 0, 0, 0);
        ci = __builtin_amdgcn_mfma_i32_16x16x64_i8(__builtin_bit_cast(v4i32, b.k[1]), __builtin_bit_cast(v4i32, a.k[1]), ci, 0, 0, 0); return __builtin_bit_cast(f32x4, ci); } };
constexpr float ACT_Q = 16.0f;
__device__ __forceinline__ unsigned q8x4(const f32x4 v) {
    const int a = (int)__builtin_rintf(fminf(fmaxf(v[0] * ACT_Q, -127.f), 127.f)), b = (int)__builtin_rintf(fminf(fmaxf(v[1] * ACT_Q, -127.f), 127.f)),
              c = (int)__builtin_rintf(fminf(fmaxf(v[2] * ACT_Q, -127.f), 127.f)), d = (int)__builtin_rintf(fminf(fmaxf(v[3] * ACT_Q, -127.f), 127.f));
    return (unsigned)(a & 255) | ((unsigned)(b & 255) << 8) | ((unsigned)(c & 255) << 16) | ((unsigned)d << 24);
}
struct EpiBf16 {
    static constexpr bool PERM = true, AFTER_DRAIN = false;
    bf16_t* O; int ldc;
    __device__ __forceinline__ void operator()(const f32x4 (&acc)[2][2][4][2], const Unit& u, int wr, int wc, int fr, int fq) const {
        epi_lane(fr, fq);
        const int row0 = u.pm * BM + wr * 64 + fr, col0 = u.pn * BM + wc * 32 + 8 * fq;
#pragma unroll
        for (int ai = 0; ai < 2; ++ai)
#pragma unroll
            for (int m = 0; m < 4; ++m) { bf16_t* rowp = O + (size_t)(row0 + ai * HALF + m * 16) * ldc + col0;
#pragma unroll
                for (int bj = 0; bj < 2; ++bj) *(u32x4*)(rowp + bj * HALF) = pack8_bf16(acc[ai][bj][m][0], acc[ai][bj][m][1]); }
    }
};
struct EpiAIn {
    static constexpr bool PERM = true, AFTER_DRAIN = false;
    bf16_t* CQ; bf16_t* CKV; float* SSQ; const float* kn; bf16_t* IK; float* IW; const float* SS; PG8_LAS float* lred;
    __device__ __forceinline__ void operator()(const f32x4 (&acc_)[2][2][4][2], const Unit& u, int wr, int wc, int fr, int fq) const {
        epi_lane(fr, fq);
        const int row0 = u.pm * BM + wr * 64 + fr, cw = wc * 32 + 8 * fq;
        float rf[2][4];
#pragma unroll
        for (int ai = 0; ai < 2; ++ai)
#pragma unroll
            for (int m = 0; m < 4; ++m) { const f32x4* sp = (const f32x4*)(SS + (size_t)(row0 + ai * HALF + m * 16) * 8); const f32x4 s0 = sp[0], s1 = sp[1];
                rf[ai][m] = __builtin_amdgcn_rsqf(((((s0[0] + s0[1]) + (s0[2] + s0[3])) + ((s1[0] + s1[1]) + (s1[2] + s1[3])))) * (1.0f / 2048.0f) + 1e-6f); }
        asm volatile("s_waitcnt vmcnt(0)" ::: "memory"); __builtin_amdgcn_sched_barrier(0);
#define AV(ai_, bj_, m_, n_) (acc_[ai_][bj_][m_][n_] * rf[ai_][m_])
        if (u.pn < 3) {
#pragma unroll
            for (int ai = 0; ai < 2; ++ai)
#pragma unroll
                for (int m = 0; m < 4; ++m) { float ss = 0.f;
#pragma unroll
                    for (int bj = 0; bj < 2; ++bj)
#pragma unroll
                        for (int n = 0; n < 2; ++n) { const f32x4 v = AV(ai, bj, m, n); ss += (v[0] * v[0] + v[1] * v[1]) + (v[2] * v[2] + v[3] * v[3]); }
                    ss += __shfl_xor(ss, 16); ss += __shfl_xor(ss, 32); if (fq == 0) lred[(ai * HALF + wr * 64 + m * 16 + fr) * 4 + wc] = ss; }
            asm volatile("s_waitcnt lgkmcnt(0)" ::: "memory"); __builtin_amdgcn_s_barrier(); asm volatile("" ::: "memory");
            if (u.pn < 2) {
#pragma unroll
                for (int ai = 0; ai < 2; ++ai)
#pragma unroll
                    for (int m = 0; m < 4; ++m) { bf16_t* rowp = CQ + (size_t)(row0 + ai * HALF + m * 16) * 512 + u.pn * BM + cw;
#pragma unroll
                        for (int bj = 0; bj < 2; ++bj) *(u32x4*)(rowp + bj * HALF) = pack8_bf16(AV(ai, bj, m, 0), AV(ai, bj, m, 1)); }
                const int t = (wr * 4 + wc) * 64 + fq * 16 + fr;
                if (t < 256) { const f32x4 p = ((const PG8_LAS f32x4*)lred)[t]; SSQ[(size_t)(u.pm * BM + t) * 2 + u.pn] = (p[0] + p[1]) + (p[2] + p[3]); }
            } else {
                f32x4 kg[2][2];
#pragma unroll
                for (int bj = 0; bj < 2; ++bj) { kg[bj][0] = *(const f32x4*)(kn + bj * HALF + cw); kg[bj][1] = *(const f32x4*)(kn + bj * HALF + cw + 4); }
#pragma unroll
                for (int ai = 0; ai < 2; ++ai)
#pragma unroll
                    for (int m = 0; m < 4; ++m) { const f32x4 p = ((const PG8_LAS f32x4*)lred)[ai * HALF + wr * 64 + m * 16 + fr];
                        const float rk = __builtin_amdgcn_rsqf(((p[0] + p[1]) + (p[2] + p[3])) * (1.0f / 256.0f) + 1e-6f);
                        bf16_t* rowp = CKV + (size_t)(row0 + ai * HALF + m * 16) * 256 + cw;
#pragma unroll
                        for (int bj = 0; bj < 2; ++bj) *(u32x4*)(rowp + bj * HALF) = pack8_bf16(AV(ai, bj, m, 0) * kg[bj][0] * rk, AV(ai, bj, m, 1) * kg[bj][1] * rk); }
            }
        } else {
            if (wc < 2) {
#pragma unroll
                for (int ai = 0; ai < 2; ++ai)
#pragma unroll
                    for (int m = 0; m < 4; ++m) { const size_t r = (size_t)(row0 + ai * HALF + m * 16);
                        *(u32x4*)(IK + ((((r >> 5) * 4 + (2 * wc + (fq >> 1))) * 64 + (fq & 1) * 32 + (r & 31)) << 3)) = pack8_bf16(AV(ai, 0, m, 0), AV(ai, 0, m, 1)); }
            } else if (wc == 2 && fq < 2) {
#pragma unroll
                for (int ai = 0; ai < 2; ++ai)
#pragma unroll
                    for (int m = 0; m < 4; ++m) { float* rowp = IW + (size_t)(row0 + ai * HALF + m * 16) * 16 + 8 * fq;
                        *(f32x4*)rowp = AV(ai, 0, m, 0) * 0.03125f; *(f32x4*)(rowp + 4) = AV(ai, 0, m, 1) * 0.03125f; }
            }
        }
#undef AV
    }
};
struct EpiQ {
    static constexpr bool PERM = true, AFTER_DRAIN = false;
    bf16_t* O; int ldc; const float* SSQ;
    __device__ __forceinline__ void operator()(const f32x4 (&acc)[2][2][4][2], const Unit& u, int wr, int wc, int fr, int fq) const {
        epi_lane(fr, fq);
        const int row0 = u.pm * BM + wr * 64 + fr, col0 = u.pn * BM + wc * 32 + 8 * fq;
        float rf[2][4];
#pragma unroll
        for (int ai = 0; ai < 2; ++ai)
#pragma unroll
            for (int m = 0; m < 4; ++m) { const size_t row = (size_t)(row0 + ai * HALF + m * 16); typedef float f32x2_ __attribute__((ext_vector_type(2))); const f32x2_ s = *(const f32x2_*)(SSQ + row * 2);
                rf[ai][m] = __builtin_amdgcn_rsqf((s[0] + s[1]) * (1.0f / 512.0f) + 1e-6f); }
        asm volatile("s_waitcnt vmcnt(0)" ::: "memory"); __builtin_amdgcn_sched_barrier(0);
#pragma unroll
        for (int ai = 0; ai < 2; ++ai)
#pragma unroll
            for (int m = 0; m < 4; ++m) { bf16_t* rowp = O + (size_t)(row0 + ai * HALF + m * 16) * ldc + col0;
#pragma unroll
                for (int bj = 0; bj < 2; ++bj) *(u32x4*)(rowp + bj * HALF) = pack8_bf16(acc[ai][bj][m][0] * rf[ai][m], acc[ai][bj][m][1] * rf[ai][m]); }
    }
};
struct EpiAGate {
    static constexpr bool PERM = true, AFTER_DRAIN = false;
    bf16_t* GATE; const float* SS; const float* CS;
    __device__ __forceinline__ void operator()(const f32x4 (&acc_)[2][2][4][2], const Unit& u, int wr, int wc, int fr, int fq) const {
        epi_lane(fr, fq);
        const int row0 = u.pm * BM + wr * 64 + fr, cw = wc * 32 + 8 * fq;
        typedef unsigned u32x2 __attribute__((ext_vector_type(2)));
        float rf[2][4];
#pragma unroll
        for (int ai = 0; ai < 2; ++ai)
#pragma unroll
            for (int m = 0; m < 4; ++m) { const f32x4* sp = (const f32x4*)(SS + (size_t)(row0 + ai * HALF + m * 16) * 8); const f32x4 s0 = sp[0], s1 = sp[1];
                rf[ai][m] = __builtin_amdgcn_rsqf(((((s0[0] + s0[1]) + (s0[2] + s0[3])) + ((s1[0] + s1[1]) + (s1[2] + s1[3])))) * (1.0f / 2048.0f) + 1e-6f); }
        f32x4 cs[2][2];
#pragma unroll
        for (int bj = 0; bj < 2; ++bj) { cs[bj][0] = *(const f32x4*)(CS + u.pn * BM + bj * HALF + cw); cs[bj][1] = *(const f32x4*)(CS + u.pn * BM + bj * HALF + cw + 4); }
        asm volatile("s_waitcnt vmcnt(0)" ::: "memory"); __builtin_amdgcn_sched_barrier(0);
#pragma unroll
        for (int ai = 0; ai < 2; ++ai)
#pragma unroll
            for (int m = 0; m < 4; ++m) { const float r = rf[ai][m];
                unsigned char* rowp = (unsigned char*)GATE + (size_t)(row0 + ai * HALF + m * 16) * 2048 + u.pn * BM + cw;
#pragma unroll
                for (int bj = 0; bj < 2; ++bj) { const f32x4 v0 = __builtin_convertvector(__builtin_bit_cast(v4i32, acc_[ai][bj][m][0]), f32x4) * (cs[bj][0] * r), v1 = __builtin_convertvector(__builtin_bit_cast(v4i32, acc_[ai][bj][m][1]), f32x4) * (cs[bj][1] * r);
                    u32x2 w; w.x = q8x4(silu4(v0)); w.y = q8x4(silu4(v1)); *(u32x2*)(rowp + bj * HALF) = w; } }
    }
};
struct EpiBIn {
    static constexpr bool PERM = true, AFTER_DRAIN = false;
    bf16_t* QKV; size_t qkv_stride; bf16_t* GATE; float* LF; const float* fbias; const float* SS; const float* CS;
    __device__ __forceinline__ void operator()(const f32x4 (&acc_)[2][2][4][2], const Unit& u, int wr, int wc, int fr, int fq) const {
        epi_lane(fr, fq);
        const int row0 = u.pm * BM + wr * 64 + fr, cw = wc * 32 + 8 * fq;
        float rf[2][4];
#pragma unroll
        for (int ai = 0; ai < 2; ++ai)
#pragma unroll
            for (int m = 0; m < 4; ++m) { const f32x4* sp = (const f32x4*)(SS + (size_t)(row0 + ai * HALF + m * 16) * 8); const f32x4 s0 = sp[0], s1 = sp[1];
                rf[ai][m] = __builtin_amdgcn_rsqf(((((s0[0] + s0[1]) + (s0[2] + s0[3])) + ((s1[0] + s1[1]) + (s1[2] + s1[3])))) * (1.0f / 2048.0f) + 1e-6f); }
        f32x4 cs[2][2], fb0 = (f32x4){0.f, 0.f, 0.f, 0.f}, fb1 = fb0;
#pragma unroll
        for (int bj = 0; bj < 2; ++bj)
#pragma unroll
            for (int n = 0; n < 2; ++n) cs[bj][n] = *(const f32x4*)(CS + u.pn * BM + bj * HALF + cw + 4 * n);
        if (u.pn == 32 && wc == 0 && fq < 2) { fb0 = *(const f32x4*)(fbias + 8 * fq); fb1 = *(const f32x4*)(fbias + 8 * fq + 4); }
        asm volatile("s_waitcnt vmcnt(0)" ::: "memory"); __builtin_amdgcn_sched_barrier(0);
        f32x4 acc[2][2][4][2];
#pragma unroll
        for (int ai = 0; ai < 2; ++ai)
#pragma unroll
            for (int m = 0; m < 4; ++m)
#pragma unroll
                for (int bj = 0; bj < 2; ++bj)
#pragma unroll
                    for (int n = 0; n < 2; ++n) acc[ai][bj][m][n] = __builtin_convertvector(__builtin_bit_cast(v4i32, acc_[ai][bj][m][n]), f32x4) * (cs[bj][n] * rf[ai][m]);
        if (u.pn < 16) {
            unsigned char* base = (unsigned char*)(QKV + (size_t)(u.pn >> 3) * qkv_stride) + (u.pn & 7) * BM + cw;
            typedef unsigned u32x2 __attribute__((ext_vector_type(2)));
#pragma unroll
            for (int ai = 0; ai < 2; ++ai)
#pragma unroll
                for (int m = 0; m < 4; ++m) { unsigned char* rowp = base + (size_t)(row0 + ai * HALF + m * 16) * 2048;
                    u32x2_t w0, w1; w0.x = q8x4(acc[ai][0][m][0]); w0.y = q8x4(acc[ai][0][m][1]); w1.x = q8x4(acc[ai][1][m][0]); w1.y = q8x4(acc[ai][1][m][1]); st8x2_wide(rowp, fq, w0, w1); }
        } else if (u.pn < 24) {
            bf16_t* base = QKV + (size_t)(u.pn >> 3) * qkv_stride + (u.pn & 7) * BM + cw;
#pragma unroll
            for (int ai = 0; ai < 2; ++ai)
#pragma unroll
                for (int m = 0; m < 4; ++m) { bf16_t* rowp = base + (size_t)(row0 + ai * HALF + m * 16) * 2048;
#pragma unroll
                    for (int bj = 0; bj < 2; ++bj) *(u32x4*)(rowp + bj * HALF) = pack8_bf16(acc[ai][bj][m][0], acc[ai][bj][m][1]); }
        } else if (u.pn < 32) {
#pragma unroll
            for (int ai = 0; ai < 2; ++ai)
#pragma unroll
                for (int m = 0; m < 4; ++m) { unsigned char* rowp = (unsigned char*)GATE + (size_t)(row0 + ai * HALF + m * 16) * 2048 + (u.pn - 24) * BM + cw; typedef unsigned u32x2 __attribute__((ext_vector_type(2)));
                    u32x2_t w0, w1; w0.x = q8x4(silu4(acc[ai][0][m][0])); w0.y = q8x4(silu4(acc[ai][0][m][1])); w1.x = q8x4(silu4(acc[ai][1][m][0])); w1.y = q8x4(silu4(acc[ai][1][m][1])); st8x2_wide(rowp, fq, w0, w1); }
        } else if (wc == 0 && fq < 2) {
            const f32x4 b0 = fb0, b1 = fb1;
#pragma unroll
            for (int ai = 0; ai < 2; ++ai)
#pragma unroll
                for (int m = 0; m < 4; ++m) { float* rowp = LF + (size_t)(row0 + ai * HALF + m * 16) * 16 + 8 * fq;
                    f32x4 x0 = acc[ai][0][m][0] + b0, x1 = acc[ai][0][m][1] + b1, y0, y1;
#pragma unroll
                    for (int i = 0; i < 4; ++i) { y0[i] = fminf(x0[i], 0.f) - __logf(1.0f + __expf(-fabsf(x0[i]))); y1[i] = fminf(x1[i], 0.f) - __logf(1.0f + __expf(-fabsf(x1[i]))); }
                    *(f32x4*)rowp = y0; *(f32x4*)(rowp + 4) = y1; }
        }
    }
};
struct EpiUV {
    static constexpr bool PERM = true, AFTER_DRAIN = false;
    bf16_t* O; const float* RS; const float* CS;
    __device__ __forceinline__ void operator()(const f32x4 (&acc)[2][2][4][2], const Unit& u, int wr, int wc, int fr, int fq) const {
        epi_lane(fr, fq);
        const int row0 = u.pm * BM + wr * 64 + fr, col0 = u.pn * BM + wc * 32 + 8 * fq;
#pragma unroll
        for (int ai = 0; ai < 2; ++ai) {
            f32x4 cs[2][2]; float rs[4];
#pragma unroll
            for (int bj = 0; bj < 2; ++bj) { cs[bj][0] = *(const f32x4*)(CS + col0 + bj * HALF); cs[bj][1] = *(const f32x4*)(CS + col0 + bj * HALF + 4); }
#pragma unroll
            for (int m = 0; m < 4; ++m) rs[m] = RS[row0 + ai * HALF + m * 16];
            asm volatile("s_waitcnt vmcnt(0)" ::: "memory"); __builtin_amdgcn_sched_barrier(0);
#pragma unroll
            for (int m = 0; m < 4; ++m) { bf16_t* rowp = O + (size_t)(row0 + ai * HALF + m * 16) * 2048 + col0;
#pragma unroll
                for (int bj = 0; bj < 2; ++bj) *(u32x4*)(rowp + bj * HALF) = pack8_bf16(__builtin_convertvector(__builtin_bit_cast(v4i32, acc[ai][bj][m][0]), f32x4) * (cs[bj][0] * rs[m]), __builtin_convertvector(__builtin_bit_cast(v4i32, acc[ai][bj][m][1]), f32x4) * (cs[bj][1] * rs[m])); }
            __builtin_amdgcn_sched_barrier(0);
        }
    }
};
template <bool BASE32  > struct EpiRes {
    static constexpr bool PERM = true, AFTER_DRAIN = false;
    const float* B32; bf16_t* OB; bf16_t* R; unsigned char* Q8; float* SSP; PG8_LAS float* lred; const float* RS; const float* CS;
    struct Raw { u32x4 w[2][2][BASE32 ? 2 : 1]; };
    __device__ __forceinline__ void load_q(Raw& q, int gq, int row0, int col0) const {
        const int ai = gq >> 1, m0 = 2 * (gq & 1);
#pragma unroll
        for (int mm = 0; mm < 2; ++mm)
#pragma unroll
            for (int bj = 0; bj < 2; ++bj) { const size_t o = (size_t)(row0 + ai * HALF + (m0 + mm) * 16) * 2048 + col0 + bj * HALF;
                if constexpr (BASE32) { q.w[mm][bj][0] = *(const u32x4*)(B32 + o); q.w[mm][bj][1] = *(const u32x4*)(B32 + o + 4); } else q.w[mm][bj][0] = *(const u32x4*)(R + o); }
    }
    __device__ __forceinline__ void operator()(const f32x4 (&acc)[2][2][4][2], const Unit& u, int wr, int wc, int fr, int fq) const {
        epi_lane(fr, fq);
        const int row0 = u.pm * BM + wr * 64 + fr, col0 = u.pn * BM + wc * 32 + 8 * fq;
        typedef unsigned u32x2 __attribute__((ext_vector_type(2)));
        f32x4 cs[2][2]; float rs[2][4];
#pragma unroll
        for (int bj = 0; bj < 2; ++bj) { cs[bj][0] = *(const f32x4*)(CS + col0 + bj * HALF); cs[bj][1] = *(const f32x4*)(CS + col0 + bj * HALF + 4); }
#pragma unroll
        for (int ai = 0; ai < 2; ++ai)
#pragma unroll
            for (int m = 0; m < 4; ++m) rs[ai][m] = RS[row0 + ai * HALF + m * 16];
        Raw qa, qb;
        load_q(qa, 0, row0, col0);
        __builtin_amdgcn_sched_barrier(0);
#define RES_QUARTER(cur_, gq_) do { const int ai = (gq_) >> 1, m0 = 2 * ((gq_) & 1); \
            _Pragma("unroll") for (int mm = 0; mm < 2; ++mm) { const int m = m0 + mm; const size_t ro = (size_t)(row0 + ai * HALF + m * 16) * 2048 + col0; float ss = 0.f; const float r_ = rs[ai][m]; \
                _Pragma("unroll") for (int bj = 0; bj < 2; ++bj) { const size_t o = ro + bj * HALF; f32x4 b0, b1; \
                    if constexpr (BASE32) { b0 = __builtin_bit_cast(f32x4, cur_.w[mm][bj][0]); b1 = __builtin_bit_cast(f32x4, cur_.w[mm][bj][BASE32 ? 1 : 0]); } \
                    else { const u32x4 g = cur_.w[mm][bj][0]; b0 = (f32x4){bf_lo(g.x), bf_hi(g.x), bf_lo(g.y), bf_hi(g.y)}; b1 = (f32x4){bf_lo(g.z), bf_hi(g.z), bf_lo(g.w), bf_hi(g.w)}; } \
                    const f32x4 v0 = b0 + __builtin_convertvector(__builtin_bit_cast(v4i32, acc[ai][bj][m][0]), f32x4) * (cs[bj][0] * r_), v1 = b1 + __builtin_convertvector(__builtin_bit_cast(v4i32, acc[ai][bj][m][1]), f32x4) * (cs[bj][1] * r_); \
                    *(u32x4*)((OB ? OB : R) + o) = pack8_bf16(v0, v1); \
                    if (Q8) { u32x2 w; w.x = q8x4(v0); w.y = q8x4(v1); *(u32x2*)(Q8 + o) = w; } \
                    ss += ((v0[0] * v0[0] + v0[1] * v0[1]) + (v0[2] * v0[2] + v0[3] * v0[3])) + ((v1[0] * v1[0] + v1[1] * v1[1]) + (v1[2] * v1[2] + v1[3] * v1[3])); } \
                if (SSP) { ss += __shfl_xor(ss, 16); ss += __shfl_xor(ss, 32); if (fq == 0) lred[(ai * HALF + wr * 64 + m * 16 + fr) * 4 + wc] = ss; } } \
            __builtin_amdgcn_sched_barrier(0); } while (0)
        if constexpr (BASE32) {
            RES_QUARTER(qa, 0); load_q(qa, 1, row0, col0); __builtin_amdgcn_sched_barrier(0); RES_QUARTER(qa, 1); load_q(qa, 2, row0, col0); __builtin_amdgcn_sched_barrier(0); RES_QUARTER(qa, 2);
            load_q(qa, 3, row0, col0); __builtin_amdgcn_sched_barrier(0); RES_QUARTER(qa, 3); (void)qb;
        } else {
            load_q(qb, 1, row0, col0); __builtin_amdgcn_sched_barrier(0); RES_QUARTER(qa, 0);
            load_q(qa, 2, row0, col0); __builtin_amdgcn_sched_barrier(0); RES_QUARTER(qb, 1);
            load_q(qb, 3, row0, col0); __builtin_amdgcn_sched_barrier(0); RES_QUARTER(qa, 2);
            RES_QUARTER(qb, 3);
        }
#undef RES_QUARTER
        if (SSP) {
            asm volatile("s_waitcnt lgkmcnt(0)" ::: "memory"); __builtin_amdgcn_s_barrier(); asm volatile("" ::: "memory");
            const int t = (wr * 4 + wc) * 64 + fq * 16 + fr;
            if (t < 256) { const f32x4 p = ((const PG8_LAS f32x4*)lred)[t]; SSP[(size_t)(u.pm * BM + t) * 8 + u.pn] = (p[0] + p[1]) + (p[2] + p[3]); }
        }
    }
};

template <class Epi, class Sched, bool ALIGN_EPI = false, bool SP2 = false, int OPK = 0  >
__device__ __forceinline__ void gemm_phase(PG8_LAS unsigned char* lds, const Gemm g, const Sched& S, const Epi& E, const int tidv) {
    const int tid = tidv, wid = __builtin_amdgcn_readfirstlane(tid >> 6), lane = tid & 63, wr = wid >> 2, wc = wid & 3, fr = lane & 15, fq = lane >> 4;
    const int K = g.K, nt = K / BK, lda = g.lda;
    unsigned voffA[2], voffB[2];
#pragma unroll
    for (int i = 0; i < 2; ++i) { int R, C; stage_rc(tid * 16 + i * 8192, R, C); const int Rb = Epi::PERM ? ((R & ~31) + perm32(R & 31)) : R;
        voffA[i] = (unsigned)(R * lda + C) * 2u; voffB[i] = (unsigned)(Rb * K + C) * 2u; }
    const size_t kstep = (size_t)(BK * 2);
    const size_t hstep = (size_t)HALF * K * 2;
    const size_t hstepA = (size_t)HALF * lda * 2, tstepA = 2 * hstepA, apn = (size_t)g.a_pn_off * 2;
    const size_t tstep = 2 * hstep;
    const unsigned ldsw = (unsigned)wid * 1024u;
    const int aoff = lds_byte(wr * 64 + fr, fq * 8), boff = lds_byte(wc * 32 + fr, fq * 8);
#define PG8_SA(b, h) (((b) * 2 + (h)) * HTB)
#define PG8_SB(b, h) ((4 + (b) * 2 + (h)) * HTB)
#define PG8_STAGE(bufoff, gbase, voff) do { _Pragma("unroll") for (int _i = 0; _i < 2; ++_i) \
        __builtin_amdgcn_global_load_lds((const unsigned*)((const char*)(gbase) + (voff)[_i]), (PG8_LAS unsigned*)(lds + (bufoff) + ldsw + _i * 8192), 16, 0, 0); } while (0)
#define PG8_LDA(dst, b, h) do { _Pragma("unroll") for (int m = 0; m < 4; ++m) FragT<OPK>::load(dst[m], lds + PG8_SA(b, h) + aoff + m * 2048); } while (0)
#define PG8_LDB(dst, b, h) do { _Pragma("unroll") for (int n = 0; n < 2; ++n) FragT<OPK>::load(dst[n], lds + PG8_SB(b, h) + boff + n * 2048); } while (0)
#define PG8_MMA(ai, bj, At, Bt) do { __builtin_amdgcn_s_setprio(1); _Pragma("unroll") for (int m = 0; m < 4; ++m) _Pragma("unroll") for (int n = 0; n < 2; ++n) { \
        acc[ai][bj][m][n] = FragT<OPK>::mma(Bt[n], At[m], acc[ai][bj][m][n]); } __builtin_amdgcn_s_setprio(0); } while (0)
#define PG8_WAIT_V(n) asm volatile("s_waitcnt vmcnt(" #n ")" ::: "memory")
#define PG8_WAIT_L(n) asm volatile("s_waitcnt lgkmcnt(" #n ")" ::: "memory")
#define PG8_BAR __builtin_amdgcn_s_barrier()
#define PG8_SCHED __builtin_amdgcn_sched_barrier(0)
    Unit cur, nxt; int ui = 0;
    if (!S.next(0, cur)) return;
    f32x4 acc[2][2][4][2];
#pragma unroll
    for (int a = 0; a < 2; ++a)
#pragma unroll
        for (int b = 0; b < 2; ++b)
#pragma unroll
            for (int m = 0; m < 4; ++m)
#pragma unroll
                for (int n = 0; n < 2; ++n) acc[a][b][m][n] = (f32x4){0.f, 0.f, 0.f, 0.f};
    typename FragT<OPK>::type At[4], B0[2], B1[2];
    const char* cA = (const char*)g.A + (size_t)cur.pm * tstepA + (size_t)cur.pn * apn; const char* cB = (const char*)g.Bt + (size_t)cur.pn * tstep;
    S.a_ready(cur);
    if constexpr (SP2) {
        PG8_STAGE(PG8_SB(0, 0), cB, voffB); PG8_STAGE(PG8_SB(0, 1), cB + hstep, voffB); PG8_STAGE(PG8_SA(0, 0), cA, voffA); PG8_STAGE(PG8_SA(0, 1), cA + hstepA, voffA);
        if (wr == 1) PG8_BAR;
        PG8_WAIT_V(2); PG8_BAR;
        PG8_STAGE(PG8_SB(1, 0), cB + kstep, voffB); PG8_STAGE(PG8_SA(1, 0), cA + kstep, voffA); PG8_STAGE(PG8_SB(1, 1), cB + hstep + kstep, voffB);
        PG8_WAIT_V(6); PG8_BAR;
    } else {
        PG8_STAGE(PG8_SB(0, 0), cB, voffB); PG8_STAGE(PG8_SA(0, 0), cA, voffA); PG8_STAGE(PG8_SB(0, 1), cB + hstep, voffB); PG8_STAGE(PG8_SA(0, 1), cA + hstepA, voffA);
        if (wr == 1) PG8_BAR;
        PG8_WAIT_V(4); PG8_BAR;
        PG8_STAGE(PG8_SB(1, 0), cB + kstep, voffB); PG8_STAGE(PG8_SA(1, 0), cA + kstep, voffA); PG8_STAGE(PG8_SB(1, 1), cB + hstep + kstep, voffB);
        PG8_WAIT_V(6); PG8_BAR;
    }
    for (;;) {
        const bool has_next = S.next(ui + 1, nxt);
        const char* nA = has_next ? (const char*)g.A + (size_t)nxt.pm * tstepA + (size_t)nxt.pn * apn : cA; const char* nB = has_next ? (const char*)g.Bt + (size_t)nxt.pn * tstep : cB;
        for (int t = 0; t < nt; t += 2) {
            const bool last = (t == nt - 2);
            const char* a1 = cA + (size_t)(t + 1) * kstep;
            const char* a2 = last ? nA : cA + (size_t)(t + 2) * kstep; const char* b2 = last ? nB : cB + (size_t)(t + 2) * kstep;
            const char* a3 = a2 + kstep; const char* b3 = b2 + kstep;
            if (last && has_next) S.a_ready(nxt);
            if constexpr (SP2) {
            PG8_LDB(B0, 0, 0); PG8_LDB(B1, 0, 1); PG8_SCHED; PG8_LDA(At, 0, 0); PG8_STAGE(PG8_SA(1, 1), a1 + hstepA, voffA);
            PG8_WAIT_V(8); PG8_WAIT_L(0); PG8_BAR; PG8_MMA(0, 0, At, B0); PG8_MMA(0, 1, At, B1); PG8_BAR; PG8_SCHED;
            PG8_LDA(At, 0, 1); PG8_STAGE(PG8_SB(0, 0), b2, voffB); PG8_STAGE(PG8_SB(0, 1), b2 + hstep, voffB); PG8_STAGE(PG8_SA(0, 0), a2, voffA);
            PG8_WAIT_V(8); PG8_WAIT_L(0); PG8_BAR; PG8_MMA(1, 0, At, B0); PG8_MMA(1, 1, At, B1); PG8_BAR; PG8_SCHED;
            PG8_LDB(B0, 1, 0); PG8_LDB(B1, 1, 1); PG8_SCHED; PG8_LDA(At, 1, 0); PG8_STAGE(PG8_SA(0, 1), a2 + hstepA, voffA);
            PG8_WAIT_V(8); PG8_WAIT_L(0); PG8_BAR; PG8_MMA(0, 0, At, B0); PG8_MMA(0, 1, At, B1); PG8_BAR; PG8_SCHED;
            PG8_LDA(At, 1, 1); PG8_STAGE(PG8_SB(1, 0), b3, voffB); PG8_STAGE(PG8_SB(1, 1), b3 + hstep, voffB); PG8_STAGE(PG8_SA(1, 0), a3, voffA);
            PG8_WAIT_V(8); PG8_WAIT_L(0); PG8_BAR; PG8_MMA(1, 0, At, B0); PG8_MMA(1, 1, At, B1); PG8_BAR; PG8_SCHED;
            } else {
            PG8_LDB(B0, 0, 0); PG8_SCHED; PG8_LDA(At, 0, 0); PG8_STAGE(PG8_SA(1, 1), a1 + hstepA, voffA);
            PG8_WAIT_L(8); PG8_BAR; PG8_WAIT_L(0); PG8_MMA(0, 0, At, B0); PG8_BAR; PG8_SCHED;
            PG8_LDB(B1, 0, 1); PG8_STAGE(PG8_SB(0, 0), b2, voffB);
            PG8_BAR; PG8_WAIT_L(0); PG8_MMA(0, 1, At, B1); PG8_BAR;
            PG8_LDA(At, 0, 1); PG8_STAGE(PG8_SA(0, 0), a2, voffA);
            PG8_BAR; PG8_WAIT_L(0); PG8_MMA(1, 0, At, B0); PG8_BAR; PG8_SCHED;
            PG8_STAGE(PG8_SB(0, 1), b2 + hstep, voffB);
            PG8_WAIT_V(6); PG8_BAR; PG8_MMA(1, 1, At, B1); PG8_BAR;
            PG8_LDB(B0, 1, 0); PG8_SCHED; PG8_LDA(At, 1, 0); PG8_STAGE(PG8_SA(0, 1), a2 + hstepA, voffA);
            PG8_WAIT_L(8); PG8_BAR; PG8_WAIT_L(0); PG8_MMA(0, 0, At, B0); PG8_BAR; PG8_SCHED;
            PG8_LDB(B1, 1, 1); PG8_STAGE(PG8_SB(1, 0), b3, voffB);
            PG8_BAR; PG8_WAIT_L(0); PG8_MMA(0, 1, At, B1); PG8_BAR;
            PG8_LDA(At, 1, 1); PG8_STAGE(PG8_SA(1, 0), a3, voffA);
            PG8_BAR; PG8_WAIT_L(0); PG8_MMA(1, 0, At, B0); PG8_BAR; PG8_SCHED;
            PG8_STAGE(PG8_SB(1, 1), b3 + hstep, voffB);
            PG8_WAIT_V(6); PG8_BAR; PG8_MMA(1, 1, At, B1); PG8_BAR;
            }
        }
        if constexpr (ALIGN_EPI) { if (wr == 0) PG8_BAR; }
        if constexpr (!Epi::AFTER_DRAIN) { E(acc, cur, wr, wc, fr, fq); S.done(cur); }
        if (!has_next) break;
#pragma unroll
        for (int a = 0; a < 2; ++a)
#pragma unroll
            for (int b = 0; b < 2; ++b)
#pragma unroll
                for (int m = 0; m < 4; ++m)
#pragma unroll
                    for (int n = 0; n < 2; ++n) acc[a][b][m][n] = (f32x4){0.f, 0.f, 0.f, 0.f};
        cur = nxt; cA = nA; cB = nB; ++ui;
        if constexpr (ALIGN_EPI) { if (wr == 1) PG8_BAR; }
    }
    PG8_WAIT_V(0);
    if constexpr (!ALIGN_EPI) { if (wr == 0) PG8_BAR; }
    PG8_BAR;
    if constexpr (Epi::AFTER_DRAIN) { E.fused(acc, cur, wr, wc, fr, fq, lds, wid, lane); S.done(cur); }
#undef PG8_SA
#undef PG8_SB
#undef PG8_STAGE
#undef PG8_LDA
#undef PG8_LDB
#undef PG8_MMA
#undef PG8_WAIT_V
#undef PG8_WAIT_L
#undef PG8_BAR
#undef PG8_SCHED
}
}

namespace fox {
enum { ORDER_NATURAL = 0, ORDER_REVERSED = 1, ORDER_PAIRED = 2, ORDER_XCD = 4 };
constexpr int D = 128, LDX = 2048;
constexpr float THR = 8.f;
constexpr bool WSKIP = false;
constexpr float SCALE = 0.08838834764831845f / 256.0f;
constexpr int NW = 8, QBLK = 32, KVBLK = 64, QB = NW * QBLK;
constexpr int SHM_V = KVBLK * D * 2, SHM_K = KVBLK * D * 2;
constexpr int LDS_BYTES = 2 * SHM_V + 2 * SHM_K + NW * 64 * 4;
constexpr int CB_OFF = LDS_BYTES;
constexpr int LDS_TOTAL = CB_OFF + 4096 * 4;

using bf16 = __hip_bfloat16;
typedef short bf16x8 __attribute__((ext_vector_type(8)));
typedef short s16x4 __attribute__((ext_vector_type(4)));
typedef float f32x16 __attribute__((ext_vector_type(16)));
typedef float f32x4 __attribute__((ext_vector_type(4)));
typedef unsigned u32x4 __attribute__((ext_vector_type(4)));
template <class A, class Bt> struct same_t { static constexpr bool v = false; };
template <class A> struct same_t<A, A> { static constexpr bool v = true; };

#define KSWZ(row, colB) ((row) * 256 + ((colB) ^ (((row) & 7) << 4)))
#define SBAR() __builtin_amdgcn_sched_barrier(0)
__device__ __forceinline__ int v_st(int k, int c) { const int kk = (k & ~0xC) | ((k & 4) << 1) | ((k & 8) >> 1); return ((kk >> 3) * 4 + (c >> 5)) * 512 + ((kk & 7) * 32 + (c & 31)) * 2; }
__device__ __forceinline__ int v_rd_base(int lane) { return ((lane & 3) << 3) | (((lane >> 2) & 3) << 6) | (((lane >> 4) & 1) << 5) | (((lane >> 5) & 1) << 8); }
constexpr int v_rd_off(int d0, int ks, int half) { return d0 * 512 + ks * 4096 + half * 2048; }
__device__ __forceinline__ int crow(int r, int hi) { return (r & 3) + 8 * (r >> 2) + 4 * hi; }
__device__ __forceinline__ unsigned cvtpk(float lo, float hi) {
    unsigned r; asm volatile("v_cvt_pk_bf16_f32 %0, %1, %2" : "=v"(r) : "v"(lo), "v"(hi)); return r;
}
__device__ __forceinline__ bf16x8 pack8(f32x4 a, f32x4 b) {
    u32x4 w = {cvtpk(a[0], a[1]), cvtpk(a[2], a[3]), cvtpk(b[0], b[1]), cvtpk(b[2], b[3])};
    return *reinterpret_cast<bf16x8*>(&w);
}
template <class T> __device__ __forceinline__ bf16x8 load8(const T* p) {
    if constexpr (same_t<T, float>::v) { return pack8(*(const f32x4*)p, *(const f32x4*)(p + 4)); }
    else { return *reinterpret_cast<const bf16x8*>(p); }
}
__device__ __forceinline__ void mask_tile(f32x16& p0, f32x16& p1, int dq, unsigned W) {
    const float NEG = -__builtin_inff();
#pragma unroll
    for (int r = 0; r < 16; ++r) {
        const int c = (r & 3) + 8 * (r >> 2);
        if ((unsigned)(dq - c) >= W) p0[r] = NEG;
        if ((unsigned)(dq - c - 32) >= W) p1[r] = NEG;
    }
}
__device__ __forceinline__ void partialSM(f32x16& p0, f32x16& p1, float& m_reg, float& mn, float& alpha) {
    float pmax = p0[0]; for (int r = 1; r < 16; ++r) pmax = fmaxf(pmax, p0[r]); for (int r = 0; r < 16; ++r) pmax = fmaxf(pmax, p1[r]);
    { auto rr = __builtin_amdgcn_permlane32_swap(__float_as_uint(pmax), __float_as_uint(pmax), false, false);
      pmax = fmaxf(__uint_as_float(rr[0]), __uint_as_float(rr[1])); }
    constexpr float C2 = 1.4426950408889634f * SCALE;
    if (__builtin_expect(__all((pmax - m_reg) * SCALE <= THR), 1)) { mn = m_reg; alpha = 1.f; }
    else { mn = fmaxf(m_reg, pmax); alpha = __builtin_amdgcn_exp2f((m_reg - mn) * C2); m_reg = mn; }
    const float mnL = -mn * C2;
    for (int r = 0; r < 16; ++r) p0[r] = fmaf(p0[r], C2, mnL); for (int r = 0; r < 16; ++r) p1[r] = fmaf(p1[r], C2, mnL);
    for (int r = 0; r < 16; ++r) p0[r] = __builtin_amdgcn_exp2f(p0[r]);
}
__device__ __forceinline__ void finishSM(f32x16& p0, f32x16& p1, float alpha, float& l_reg, bf16x8& pa0, bf16x8& pa1, bf16x8& pa2, bf16x8& pa3) {
    for (int r = 0; r < 16; ++r) p1[r] = __builtin_amdgcn_exp2f(p1[r]);
    float ps = 0; for (int r = 0; r < 16; ++r) ps += p0[r]; for (int r = 0; r < 16; ++r) ps += p1[r];
    { auto rr = __builtin_amdgcn_permlane32_swap(__float_as_uint(ps), __float_as_uint(ps), false, false);
      ps = __uint_as_float(rr[0]) + __uint_as_float(rr[1]); }
    l_reg = l_reg * alpha + ps;
#define PK4(P, B_, OUT) do { unsigned a0 = cvtpk(P[B_+0], P[B_+1]), a1 = cvtpk(P[B_+2], P[B_+3]);                          \
        unsigned b0 = cvtpk(P[B_+4], P[B_+5]), b1 = cvtpk(P[B_+6], P[B_+7]);                                             \
        auto r0 = __builtin_amdgcn_permlane32_swap(a0, b0, false, false); auto r1 = __builtin_amdgcn_permlane32_swap(a1, b1, false, false); \
        u32x4 w = {r0[0], r1[0], r0[1], r1[1]}; OUT = *reinterpret_cast<bf16x8*>(&w); } while (0)
    PK4(p0, 0, pa0); PK4(p0, 8, pa1); PK4(p1, 0, pa2); PK4(p1, 8, pa3);
#undef PK4
}
template <int KB, bool SK>
__device__ __forceinline__ void qkt(f32x16& p0, f32x16& p1, const char* K_lds, int r32, int hi, const bf16x8* qr, bool act, const int* cbt) {
    typedef int v16i __attribute__((ext_vector_type(16))); typedef int v4i_ __attribute__((ext_vector_type(4)));
    v16i a0, a1;
    { int hi2 = hi; asm volatile("" : "+v"(hi2));
      const v4i_* c4 = (const v4i_*)cbt + hi2;
      const v4i_ x0 = c4[0], x1 = c4[2], x2 = c4[4], x3 = c4[6], y0 = c4[8], y1 = c4[10], y2 = c4[12], y3 = c4[14];
      a0 = (v16i){x0[0], x0[1], x0[2], x0[3], x1[0], x1[1], x1[2], x1[3], x2[0], x2[1], x2[2], x2[3], x3[0], x3[1], x3[2], x3[3]};
      a1 = (v16i){y0[0], y0[1], y0[2], y0[3], y1[0], y1[1], y1[2], y1[3], y2[0], y2[1], y2[2], y2[3], y3[0], y3[1], y3[2], y3[3]}; }
    const char* kb[4];
#pragma unroll
    for (int s = 0; s < 4; ++s) kb[s] = K_lds + KB * SHM_K + r32 * 128 + 16 * ((2 * s + hi) ^ ((r32 >> 1) & 7));
#pragma unroll
    for (int s = 0; s < 4; ++s) {
        const v4i_ b0 = *reinterpret_cast<const v4i_*>(kb[s]), b1 = *reinterpret_cast<const v4i_*>(kb[s] + 32 * 128), q = __builtin_bit_cast(v4i_, qr[s]);
        a0 = __builtin_amdgcn_mfma_i32_32x32x32_i8(b0, q, a0, 0, 0, 0);
        a1 = __builtin_amdgcn_mfma_i32_32x32x32_i8(b1, q, a1, 0, 0, 0); }
    p0 = __builtin_convertvector(a0, f32x16); p1 = __builtin_convertvector(a1, f32x16);
}
template <int VB, bool SK>
__device__ __forceinline__ void pv_tile(f32x16* o, int vb0, bf16x8 pa0, bf16x8 pa1, bf16x8 pa2, bf16x8 pa3, bool act) {
    if (SK && !act) return;
#define TRRD(dst, off) asm volatile("ds_read_b64_tr_b16 %0, %1 offset:%2" : "=&v"(dst) : "v"(vb0), "i"(off) : "memory")
#define PV_D0(d0) do { s16x4 l0, l1, l2, l3, h0, h1, h2, h3; constexpr int b_ = VB * SHM_V + v_rd_off(d0, 0, 0);     \
        TRRD(l0, b_); TRRD(h0, b_ + 2048); TRRD(l1, b_ + 4096); TRRD(h1, b_ + 6144); TRRD(l2, b_ + 8192); TRRD(h2, b_ + 10240); TRRD(l3, b_ + 12288); TRRD(h3, b_ + 14336); \
        asm volatile("s_waitcnt lgkmcnt(0)" ::: "memory"); SBAR();                 \
        o[d0] = __builtin_amdgcn_mfma_f32_32x32x16_bf16(pa0, (bf16x8){l0[0], l0[1], l0[2], l0[3], h0[0], h0[1], h0[2], h0[3]}, o[d0], 0, 0, 0);   \
        o[d0] = __builtin_amdgcn_mfma_f32_32x32x16_bf16(pa1, (bf16x8){l1[0], l1[1], l1[2], l1[3], h1[0], h1[1], h1[2], h1[3]}, o[d0], 0, 0, 0);   \
        o[d0] = __builtin_amdgcn_mfma_f32_32x32x16_bf16(pa2, (bf16x8){l2[0], l2[1], l2[2], l2[3], h2[0], h2[1], h2[2], h2[3]}, o[d0], 0, 0, 0);   \
        o[d0] = __builtin_amdgcn_mfma_f32_32x32x16_bf16(pa3, (bf16x8){l3[0], l3[1], l3[2], l3[3], h3[0], h3[1], h3[2], h3[3]}, o[d0], 0, 0, 0); } while (0)
    PV_D0(0); PV_D0(1); PV_D0(2); PV_D0(3);
#undef PV_D0
#undef TRRD
}

template <class TIn, class TOut> struct BlockRef { const unsigned char* Q8; const unsigned char* K8; const TIn* Vp; TOut* Op; const unsigned char* Gp; int P0; int R0; int HH;
    __device__ __forceinline__ const TIn* V() const { return Vp; }
    __device__ __forceinline__ TOut* O() const { return Op; }
    __device__ __forceinline__ const unsigned char* G() const { return Gp; } };
template <class TIn> struct Seam {
    bf16x8 qr[8];
    bf16x8 st_v0, st_v1, st_k0, st_k1; f32x4 sf0, sf1, sf2, sf3;
    f32x4 tq[16];
};
__device__ __forceinline__ int swa_jlo(int P0, int W) { const int lowk = P0 - W + 1; return lowk > 0 ? lowk / KVBLK : 0; }
#define ROW(p, k0, rr) ((const TIn*)((const char*)((p) + (size_t)(k0) * LDX) + (unsigned)(((rr) * LDX + sc) * 2)))
#define VMW() asm volatile("s_waitcnt vmcnt(0)" ::: "memory")
#define VMWN(n) asm volatile("s_waitcnt vmcnt(%0)" :: "i"(n) : "memory")
#define SLOAD_H(Kp, Vp, k0) do { S.st_v0 = load8<TIn>(ROW(Vp, k0, sr)); S.st_v1 = load8<TIn>(ROW(Vp, k0, 32 + sr));              \
                         S.st_k0 = *(const bf16x8*)((Kp) + (size_t)(k0) * LDX + kg8); } while (0)
#define SWRITE_HK(bf) do { *(bf16x8*)(K_lds + (bf) * SHM_K + kws) = S.st_k0; } while (0)
#define SWRITE_HV(bf) do { *(bf16x8*)(V_lds + (bf) * SHM_V + vst0) = S.st_v0; *(bf16x8*)(V_lds + (bf) * SHM_V + vst1) = S.st_v1; } while (0)
#define SWRITE_H(bf) do { SWRITE_HV(bf); SWRITE_HK(bf); } while (0)
#define SLOAD_F(p, k0) do { S.sf0 = *(const f32x4*)ROW(p, k0, sr); S.sf1 = *(const f32x4*)(ROW(p, k0, sr) + 4);                \
                            S.sf2 = *(const f32x4*)ROW(p, k0, 32 + sr); S.sf3 = *(const f32x4*)(ROW(p, k0, 32 + sr) + 4); } while (0)
#define SWRITE_KF(bf) do { *(bf16x8*)(K_lds + (bf) * SHM_K + kws) = pack8(S.sf0, S.sf1); *(bf16x8*)(K_lds + (bf) * SHM_K + kws + 32 * 256) = pack8(S.sf2, S.sf3); } while (0)
#define SWRITE_VF(bf) do { *(bf16x8*)(V_lds + (bf) * SHM_V + vst0) = pack8(S.sf0, S.sf1); *(bf16x8*)(V_lds + (bf) * SHM_V + vst1) = pack8(S.sf2, S.sf3); } while (0)
template <class TIn, class TOut>
__device__ __forceinline__ void causal_swa_prime(const BlockRef<TIn, TOut>& cur, int W, char* lds, Seam<TIn>& S, const int tidv) {
    constexpr bool F32 = same_t<TIn, float>::v;
    const int tid = tidv, wid = __builtin_amdgcn_readfirstlane(tid >> 6), lane = tid & 63, r32 = lane & 31, hi = lane >> 5;
    const int sr = tid >> 4, sc = (tid & 15) * 8, kr8 = tid >> 3, kc8 = tid & 7, kws = kr8 * 128 + 16 * (kc8 ^ ((kr8 >> 1) & 7)); const unsigned kg8 = (unsigned)(kr8 * LDX + kc8 * 16); char* K_lds = lds + 2 * SHM_V;
    const int kb0 = swa_jlo(cur.P0, W) * KVBLK;
    for (int d0 = 0; d0 < 4; ++d0) S.qr[d0] = *(const bf16x8*)(cur.Q8 + (size_t)(wid * QBLK) * LDX + (unsigned)(r32 * LDX + hi * 16) + d0 * 32);
    if constexpr (F32) { SLOAD_F((const float*)cur.K, kb0); VMW(); SWRITE_KF(0); SBAR(); SLOAD_F((const float*)cur.V(), kb0); }
    else { SLOAD_H(cur.K8, cur.V(), kb0); VMW(); SWRITE_HK(0); }
    __syncthreads();
}
template <class TIn, class TOut>
__device__ __forceinline__ void causal_swa_block(const BlockRef<TIn, TOut>& cur, const BlockRef<TIn, TOut>& nxt, int skv, int W, char* lds, Seam<TIn>& S, const int tidv, float* RMAX) {
    constexpr bool F32 = same_t<TIn, float>::v;
    const int tid = tidv, wid = __builtin_amdgcn_readfirstlane(tid >> 6), lane = tid & 63, r32 = lane & 31, hi = lane >> 5;
    const int j_lo = swa_jlo(cur.P0, W);
    int j_hi = (cur.P0 + QB - 1) / KVBLK + 1; if (j_hi > skv / KVBLK) j_hi = skv / KVBLK;
    const int NT = j_hi - j_lo;
    const int kbn = swa_jlo(nxt.P0, W) * KVBLK;
    const int qlo = cur.P0 + wid * QBLK, qm = qlo + r32 - 4 * hi;
    char* V_lds = lds; char* K_lds = lds + 2 * SHM_V;
    float* ws = (float*)(lds + 2 * SHM_V + 2 * SHM_K) + wid * 64; float* li_l = ws, * al_l = ws + 32;
    const int* cbl = (const int*)(lds + CB_OFF);
    float m_reg = -1e30f, l_reg = 0; f32x16 o[4] = {};
    const int sr = tid >> 4, sc = (tid & 15) * 8, vst0 = v_st(sr, sc), vst1 = v_st(32 + sr, sc), kr8 = tid >> 3, kc8 = tid & 7, kws = kr8 * 128 + 16 * (kc8 ^ ((kr8 >> 1) & 7));
    const unsigned kg8 = (unsigned)(kr8 * LDX + kc8 * 16);
    const int vb0 = (int)(uintptr_t)V_lds + v_rd_base(lane);
    const unsigned char* Kh = cur.K8; const TIn* Vh = cur.V();
#define RESC(a) do { if (__any((a) < 1.f)) { if (hi == 0) al_l[r32] = (a); asm volatile("s_waitcnt lgkmcnt(0)" ::: "memory");              \
                     for (int d_ = 0; d_ < 4; ++d_) for (int r = 0; r < 16; ++r) o[d_][r] *= al_l[crow(r, hi)]; } } while (0)
#define KBASE(t) ((j_lo + (t)) * KVBLK)
#define ACT(t) (KBASE(t) <= qlo + QBLK - 1 && KBASE(t) + KVBLK - 1 >= qlo - W + 1)
#define MASKT(P0_, P1_, t) do { const int kb_ = KBASE(t); if ((!SK || ACT(t)) && (kb_ + KVBLK - 1 > qlo || kb_ <= qlo + QBLK - 1 - W)) mask_tile(P0_, P1_, qm - kb_, (unsigned)W); } while (0)
    constexpr int NQL = F32 ? 16 : 4;
    constexpr bool SK = WSKIP && !F32;
#define SEAM_K0() do { VMWN(NQL); if constexpr (F32) { SWRITE_KF(0); SBAR(); SLOAD_F((const float*)nxt.V(), kbn); } else { SWRITE_HK(0); } SBAR(); } while (0)
    f32x16 pA0, pA1, pB0, pB1; float mnA, mnB, alA, alB; bf16x8 pa0, pa1, pa2, pa3;
    if constexpr (F32) { VMW(); SWRITE_VF(0); SBAR(); } else { SWRITE_HV(0); SBAR(); }
    if (NT > 1) { if constexpr (F32) SLOAD_F((const float*)Kh, KBASE(1)); else SLOAD_H(Kh, Vh, KBASE(1)); }
    SBAR(); qkt<0, SK>(pA0, pA1, K_lds, r32, hi, S.qr, ACT(0), cbl + KBASE(0));
    if constexpr (F32) { if (NT > 1) { VMW(); SWRITE_KF(1); SBAR(); SLOAD_F((const float*)Vh, KBASE(1)); } }
    MASKT(pA0, pA1, 0); partialSM(pA0, pA1, m_reg, mnA, alA);
    if (NT > 1) { VMW(); if constexpr (F32) { SWRITE_VF(1); SBAR(); if (NT > 2) SLOAD_F((const float*)Kh, KBASE(2)); } else SWRITE_H(1); }
    __syncthreads();
#define HALF_STEP(PX0, PX1, mnX, alX, PY0, PY1, alY, t, KB, VB, SB) do {                                                      \
        SBAR(); qkt<KB, SK>(PX0, PX1, K_lds, r32, hi, S.qr, ACT(t), cbl + KBASE(t));                                             \
        finishSM(PY0, PY1, alY, l_reg, pa0, pa1, pa2, pa3); SBAR();                                                           \
        if ((t) + 1 < NT) { if constexpr (F32) { VMW(); SWRITE_KF(SB); SBAR(); SLOAD_F((const float*)Vh, KBASE((t) + 1)); }  \
                            else { SLOAD_H(Kh, Vh, KBASE((t) + 1)); } SBAR(); }                                               \
        pv_tile<VB, SK>(o, vb0, pa0, pa1, pa2, pa3, ACT((t) - 1)); MASKT(PX0, PX1, (t)); partialSM(PX0, PX1, m_reg, mnX, alX);                                        \
        __syncthreads();                                                                                                      \
        if ((t) + 1 < NT) { VMW(); if constexpr (F32) { SWRITE_VF(SB); SBAR(); if ((t) + 2 < NT) SLOAD_F((const float*)Kh, KBASE((t) + 2)); } \
                            else { SWRITE_H(SB); } }                                                                          \
        RESC(alX); __syncthreads(); } while (0)
    for (int t = 1; t + 1 < NT; t += 2) {
        HALF_STEP(pB0, pB1, mnB, alB, pA0, pA1, alA, t, 1, 0, 0);
        HALF_STEP(pA0, pA1, mnA, alA, pB0, pB1, alB, t + 1, 0, 1, 1);
    }
    const bool even = (NT & 1) == 0;
    if (even) { SBAR(); qkt<1, SK>(pB0, pB1, K_lds, r32, hi, S.qr, ACT(NT - 1), cbl + KBASE(NT - 1)); SBAR(); }
#define QROW(e) (nxt.Q + (size_t)(wid * QBLK + r32) * LDX + ((e) >> 1) * 16 + hi * 8 + ((e) & 1) * 4)
    if constexpr (F32) { SLOAD_F((const float*)nxt.K, kbn); SBAR();
#pragma unroll
        for (int e = 0; e < 8; ++e) S.tq[e] = *(const f32x4*)QROW(e); }
    else { SLOAD_H(nxt.K8, nxt.V(), kbn); SBAR();
#pragma unroll
        for (int d0 = 0; d0 < 4; ++d0) S.qr[d0] = *(const bf16x8*)(nxt.Q8 + (size_t)(wid * QBLK) * LDX + (unsigned)(r32 * LDX + hi * 16) + d0 * 32); }
    SBAR();
    finishSM(pA0, pA1, alA, l_reg, pa0, pa1, pa2, pa3); SBAR();
    if constexpr (F32) {
#pragma unroll
        for (int e = 8; e < 16; ++e) S.tq[e] = *(const f32x4*)QROW(e); SBAR(); }
#undef QROW
    pv_tile<0, SK>(o, vb0, pa0, pa1, pa2, pa3, ACT(even ? NT - 2 : NT - 1));
    if (even) { MASKT(pB0, pB1, NT - 1); partialSM(pB0, pB1, m_reg, mnB, alB); __syncthreads(); RESC(alB);
        finishSM(pB0, pB1, alB, l_reg, pa0, pa1, pa2, pa3); SBAR(); pv_tile<1, SK>(o, vb0, pa0, pa1, pa2, pa3, ACT(NT - 1)); }
    SBAR(); SEAM_K0();
    int r32e = r32, hie = hi; asm volatile("" : "+v"(r32e), "+v"(hie));
    if (hie == 0) li_l[r32e] = l_reg; asm volatile("s_waitcnt lgkmcnt(0)" ::: "memory");
    float rli[16];
#pragma unroll
    for (int r = 0; r < 16; ++r) rli[r] = __builtin_amdgcn_rcpf(li_l[crow(r, hie)]);
    TOut* Ow = cur.O() + (size_t)(wid * QBLK) * LDX;
#pragma unroll
    for (int r = 0; r < 16; ++r) { const int orow = crow(r, hie);
#pragma unroll
        for (int d0 = 0; d0 < 4; ++d0) { const float v = o[d0][r] * rli[r];
            const float vn = __shfl_xor(v, 1);
            if ((r32e & 1) == 0) *(unsigned*)(Ow + (size_t)orow * LDX + d0 * 32 + r32e) = cvtpk(v, vn); } }
    if constexpr (F32) {
#pragma unroll
        for (int d0 = 0; d0 < 8; ++d0) S.qr[d0] = pack8(S.tq[2 * d0], S.tq[2 * d0 + 1]); }
    __syncthreads();
#undef RESC
#undef KBASE
#undef ACT
#undef MASKT
#undef SEAM_K0
#undef HALF_STEP
}
#undef ROW
#undef VMW
#undef VMWN
#undef SLOAD_H
#undef SWRITE_HK
#undef SWRITE_HV
#undef SWRITE_H
#undef SLOAD_F
#undef SWRITE_KF
#undef SWRITE_VF

struct SwaItem { int bh, qb0, qb1; };
__device__ __forceinline__ SwaItem swa_decode(int L) {
    constexpr int nx = 8, nqb = 16;
    const int xcd = L & 7, k = L >> 3, gi = k / nx, x = k - gi * nx; SwaItem it; it.bh = gi * 8 + xcd;
    it.qb0 = x; it.qb1 = nqb - 1 - x; return it;
}
struct Tensors { const unsigned char* Q8; const unsigned char* K8; const bf16* V; bf16* O; const unsigned char* G; const float* CB; float* RMAX; };
__device__ __forceinline__ BlockRef<bf16, bf16> swa_ref(const SwaItem& it, int pass, const Tensors& T) {
    const int qb = pass ? it.qb1 : it.qb0, b = it.bh >> 4, h = it.bh & 15;
    const size_t qoff = ((size_t)b * 4096 + (size_t)qb * QB) * LDX + (size_t)h * D, koff = (size_t)b * 4096 * LDX + (size_t)h * D;
    BlockRef<bf16, bf16> r; r.Q8 = T.Q8 + qoff; r.K8 = T.K8 + koff; r.Vp = T.V + koff; r.Op = T.O + qoff; r.Gp = T.G + qoff; r.P0 = qb * QB; r.R0 = b * 4096 + qb * QB; r.HH = h; return r;
}
__device__ __forceinline__ void load_cb(char* lds, const float* CB, int bh, const int tid) {
    int t2 = tid; asm volatile("" : "+v"(t2)); const int tid_ = t2;
    const f32x4* src = (const f32x4*)(CB + (size_t)bh * 4096); f32x4* dst = (f32x4*)(lds + CB_OFF);
    const f32x4 a = src[tid_], b = src[tid_ + 512];
    dst[tid_] = a; dst[tid_ + 512] = b;
    __syncthreads();
}
__device__ __forceinline__ void attn_phase(char* lds, const Tensors& T, int grid, int bid, const int tidv) {
    constexpr int total = 1024, W = 4096, skv = 4096;
    int L = bid; if (L >= total) return;
    SwaItem it = swa_decode(L); int pass = 0;
    BlockRef<bf16, bf16> cur = swa_ref(it, 0, T);
    Seam<bf16> S;
    load_cb(lds, T.CB, it.bh, tidv);
    causal_swa_prime<bf16, bf16>(cur, W, lds, S, tidv);
    for (;;) {
        const bool more_pass = pass == 0 && it.qb1 != it.qb0, more_item = L + grid < total, last = !more_pass && !more_item;
        SwaItem itn = it; int passn = pass + 1, Ln = L;
        if (!more_pass) { passn = 0; Ln = more_item ? L + grid : L; itn = swa_decode(Ln); }
        const BlockRef<bf16, bf16> nxt = last ? cur : swa_ref(itn, passn, T);
        causal_swa_block<bf16, bf16>(cur, nxt, skv, W, lds, S, tidv, T.RMAX);
        if (last) break;
        cur = nxt; it = itn; pass = passn; L = Ln;
        if (pass == 0) load_cb(lds, T.CB, it.bh, tidv);
    }
}
#undef KSWZ
#undef SBAR
}

constexpr int NWAVES = 8;
constexpr int CW_TMO = 0, CW_CODE = 1;
constexpr int CW_BAR = 4096;
constexpr int RING_OFF = 0, RING_BYTES = 131072;
constexpr int AUX_OFF = RING_BYTES, AUX_BYTES = 20480;
constexpr int LDSCTL_OFF = AUX_OFF + AUX_BYTES, MISC_OFF = LDSCTL_OFF + 320;
constexpr int LDS_BYTES = LDSCTL_OFF + 1024;
static_assert(fox::LDS_TOTAL <= RING_BYTES && MISC_OFF + 128 <= LDS_BYTES, "LDS map");

#define GAS __attribute__((address_space(1)))
#define LAS __attribute__((address_space(3)))
typedef unsigned short bf16;
typedef unsigned v4u __attribute__((ext_vector_type(4)));
typedef unsigned v2u __attribute__((ext_vector_type(2)));
typedef int v4i __attribute__((ext_vector_type(4)));
typedef float f32x4 __attribute__((ext_vector_type(4)));
typedef float f32x16 __attribute__((ext_vector_type(16)));
typedef short bf16x8 __attribute__((ext_vector_type(8)));
typedef short s16x4 __attribute__((ext_vector_type(4)));
typedef short v4i16_t __attribute__((ext_vector_type(4)));
typedef GAS unsigned gu32;
#define RLX_AGENT __ATOMIC_RELAXED, __HIP_MEMORY_SCOPE_AGENT
#define LDS_WAIT() asm volatile("s_waitcnt lgkmcnt(0)" ::: "memory")
#define VM_WAIT() asm volatile("s_waitcnt vmcnt(0)" ::: "memory")
__device__ __forceinline__ unsigned f2bf(float f) { unsigned u = __builtin_bit_cast(unsigned, f); return (u + 0x7fffu + ((u >> 16) & 1u)) >> 16; }
__device__ __forceinline__ unsigned pk2(float lo, float hi) { return f2bf(lo) | (f2bf(hi) << 16); }

#define XB_TMO      128
#define XB_XCNT(j)  (256  + 64 * (j))
#define XB_XSUB(j)  (1280 + 64 * (j))
#define XB_XGEN(j)  (2304 + 64 * (j))
#define XB_TOP      3328
#define XB_TOPGEN   3392
#define XCD_BAR_WORDS 3456
#define XB_SPIN_CAP (1u << 18)

__device__ __forceinline__ unsigned xb_ld(unsigned* p)              { return __hip_atomic_load(p, __ATOMIC_RELAXED, __HIP_MEMORY_SCOPE_AGENT); }
__device__ __forceinline__ unsigned xb_add(unsigned* p, unsigned v) { return __hip_atomic_fetch_add(p, v, __ATOMIC_RELAXED, __HIP_MEMORY_SCOPE_AGENT); }
__device__ __forceinline__ unsigned xb_xcc_id() { return (unsigned)__builtin_amdgcn_s_getreg((3 << 11) | 20) & 0xFu; }
#define XB_SPIN(cond, bar) do { unsigned _sp = 0; while (cond) { __builtin_amdgcn_s_sleep(1); \
    if ((++_sp & 255u) == 0u) { if (xb_ld(&(bar)[XB_TMO])) break; if (_sp > XB_SPIN_CAP) { atomicAdd(&(bar)[XB_TMO], 1u); break; } } } } while (0)

struct XcdBarrier {
    unsigned* bar; unsigned x;
    volatile LAS unsigned* st;
};

__device__ __forceinline__ XcdBarrier xcd_barrier_post(unsigned* bar, volatile LAS unsigned* st, const bool leader  ) {
    XcdBarrier b; b.bar = bar; b.x = xb_xcc_id(); b.st = st;
    if (leader) (void)xb_add(&bar[XB_XCNT(b.x)], 1u);
    return b;
}
__device__ __forceinline__ void xcd_barrier_complete(unsigned* bar, unsigned x, unsigned& nloc, unsigned& nx) {
    const unsigned G = gridDim.x * gridDim.y * gridDim.z;
    unsigned sum, cnt, mine, sp = 0u;
    for (;;) {
        sum = 0u; cnt = 0u; mine = 0u;
#pragma unroll
        for (unsigned j = 0; j < 16; ++j) { const unsigned c = xb_ld(&bar[XB_XCNT(j)]); sum += c; cnt += (c > 0u) ? 1u : 0u; mine = (j == x) ? c : mine; }
        if (sum == G) break;
        __builtin_amdgcn_s_sleep(1);
        if ((++sp & 255u) == 0u) { if (xb_ld(&bar[XB_TMO])) break; if (sp > XB_SPIN_CAP) { atomicAdd(&bar[XB_TMO], 1u); break; } }
    }
    nloc = mine > 0u ? mine : 1u; nx = cnt > 0u ? cnt : 1u;
}

__device__ __forceinline__ void xcd_barrier(const XcdBarrier& b, const bool leader  ) {
    asm volatile("s_waitcnt vmcnt(0)" ::: "memory");
    __syncthreads();
    if (leader) {
        unsigned* bar = b.bar;
        __builtin_amdgcn_s_waitcnt(0);
        unsigned nloc = b.st[0], nx = b.st[1];
        if (nloc == 0u) { xcd_barrier_complete(bar, b.x, nloc, nx); b.st[0] = nloc; b.st[1] = nx; }
        const unsigned old = xb_add(&bar[XB_XSUB(b.x)], 1u);
        const unsigned gen = old / nloc;
        if (old + 1u == (gen + 1u) * nloc) {
            __builtin_amdgcn_fence(__ATOMIC_RELEASE, "agent");
            asm volatile("s_waitcnt vmcnt(0)" ::: "memory");
            const unsigned og = xb_add(&bar[XB_TOP], 1u);
            const unsigned tg = og / nx;
            if (og + 1u == (tg + 1u) * nx) xb_add(&bar[XB_TOPGEN], 1u);
            else XB_SPIN(xb_ld(&bar[XB_TOPGEN]) == tg, bar);
            __builtin_amdgcn_fence(__ATOMIC_ACQUIRE, "agent");
            xb_add(&bar[XB_XGEN(b.x)], 1u);
            asm volatile("s_waitcnt vmcnt(0)" ::: "memory");
        } else {
            XB_SPIN(xb_ld(&bar[XB_XGEN(b.x)]) == gen, bar);
            __builtin_amdgcn_fence(__ATOMIC_ACQUIRE, "agent");
            asm volatile("s_waitcnt vmcnt(0)" ::: "memory");
        }
    }
    __syncthreads();
}


__device__ __forceinline__ float wave_sum(float v) {
#pragma unroll
    for (int o = 1; o < 64; o <<= 1) v += __shfl_xor(v, o);
    return v;
}
__device__ __forceinline__ void tr_item(const float* W, int K, int Nsrc, int src_col0, int lim, bf16* WT, int dst_row0, int nblk, LAS float* scr, int item, int lane, const float* gain  ) {
    const int kb = item / nblk, nb = item % nblk, k0 = 64 * kb, n0 = 32 * nb, col = src_col0 + n0 + (lane & 31);
    float wv[32];
#pragma unroll
    for (int i = 0; i < 32; ++i) { const int kk = 2 * i + (lane >> 5); wv[i] = col < lim ? W[(size_t)(k0 + kk) * Nsrc + col] : 0.f; }
#pragma unroll
    for (int i = 0; i < 32; ++i) { const int kk = 2 * i + (lane >> 5); const float gk = gain ? gain[k0 + kk] : 1.0f; scr[kk * 33 + (lane & 31)] = wv[i] * gk; }
    LDS_WAIT(); asm volatile("" ::: "memory");
    const int c = lane & 7;
#pragma unroll
    for (int j = 0; j < 4; ++j) { const int n = (lane >> 3) + 8 * j; const LAS float* s = scr + (8 * c) * 33 + n;
        v4u o; o.x = pk2(s[0 * 33], s[1 * 33]); o.y = pk2(s[2 * 33], s[3 * 33]); o.z = pk2(s[4 * 33], s[5 * 33]); o.w = pk2(s[6 * 33], s[7 * 33]);
        *(GAS v4u*)(WT + (size_t)(dst_row0 + n0 + n) * K + k0 + 8 * c) = o; }
    LDS_WAIT(); asm volatile("" ::: "memory");
}
__device__ __forceinline__ unsigned pk4_fp8(float a, float b, float c, float d) { int w = 0; w = __builtin_amdgcn_cvt_pk_fp8_f32(a, b, w, false); w = __builtin_amdgcn_cvt_pk_fp8_f32(c, d, w, true); return (unsigned)w; }
__device__ __forceinline__ void tr_item_f8(const float* W, int K, int Nsrc, int src_col0, int lim, unsigned char* WT, int dst_row0, int nblk, LAS float* scr, int item, int lane, float scale) {
    const int kb = item / nblk, nb = item % nblk, k0 = 64 * kb, n0 = 32 * nb, col = src_col0 + n0 + (lane & 31);
#pragma unroll 8
    for (int i = 0; i < 32; ++i) { const int kk = 2 * i + (lane >> 5); scr[kk * 33 + (lane & 31)] = col < lim ? W[(size_t)(k0 + kk) * Nsrc + col] * scale : 0.f; }
    LDS_WAIT(); asm volatile("" ::: "memory");
    const int c = lane & 7;
#pragma unroll
    for (int j = 0; j < 4; ++j) { const int n = (lane >> 3) + 8 * j; const LAS float* s = scr + (8 * c) * 33 + n;
        v2u o; o.x = pk4_fp8(s[0 * 33], s[1 * 33], s[2 * 33], s[3 * 33]); o.y = pk4_fp8(s[4 * 33], s[5 * 33], s[6 * 33], s[7 * 33]);
        *(GAS v2u*)(WT + (size_t)(dst_row0 + n0 + n) * K + k0 + 8 * c) = o; }
    LDS_WAIT(); asm volatile("" ::: "memory");
}
__device__ __forceinline__ void colmax_item(const float* W, int Nsrc, int src_col0, int lim, unsigned* cmax, int dst_row0, int nblk, int item, int lane, const float* gain) {
    const int kb = item / nblk, nb = item % nblk, k0 = 64 * kb, n0 = 32 * nb, col = src_col0 + n0 + (lane & 31);
    float m = 0.f;
    if (col < lim) {
        float wv[32];
#pragma unroll
        for (int i = 0; i < 32; ++i) { const int kk = k0 + 2 * i + (lane >> 5); wv[i] = W[(size_t)kk * Nsrc + col]; }
#pragma unroll
        for (int i = 0; i < 32; ++i) { const int kk = k0 + 2 * i + (lane >> 5); m = fmaxf(m, fabsf(wv[i] * (gain ? gain[kk] : 1.0f))); }
    }
    m = fmaxf(m, __shfl_xor(m, 32));
    if (lane < 32) atomicMax(cmax + dst_row0 + n0 + lane, __float_as_uint(m));
}
__device__ __forceinline__ void tr_item_i8(const float* W, int K, int Nsrc, int src_col0, int lim, unsigned char* WT, int dst_row0, int nblk, LAS float* scr, int item, int lane, const float* gain  , const unsigned* cmax, float* CS, const float act_inv  ) {
    const int kb = item / nblk, nb = item % nblk, k0 = 64 * kb, n0 = 32 * nb, col = src_col0 + n0 + (lane & 31);
    const float cm = __uint_as_float(cmax[dst_row0 + n0 + (lane & 31)]), qs = cm > 0.f ? 127.0f / cm : 0.f;
    if (kb == 0 && lane < 32) CS[dst_row0 + n0 + lane] = cm * (1.0f / 127.0f) * act_inv;
    float wv[32];
#pragma unroll
    for (int i = 0; i < 32; ++i) { const int kk = 2 * i + (lane >> 5); wv[i] = col < lim ? W[(size_t)(k0 + kk) * Nsrc + col] : 0.f; }
#pragma unroll
    for (int i = 0; i < 32; ++i) { const int kk = 2 * i + (lane >> 5); scr[kk * 33 + (lane & 31)] = wv[i] * (gain ? gain[k0 + kk] : 1.0f) * qs; }
    LDS_WAIT(); asm volatile("" ::: "memory");
    const int c = lane & 7;
#pragma unroll
    for (int j = 0; j < 4; ++j) { const int n = (lane >> 3) + 8 * j; const LAS float* s = scr + (8 * c) * 33 + n;
        v2u o;
#define Q8(x) ((unsigned)((int)__builtin_rintf(fminf(fmaxf((x), -127.f), 127.f)) & 255))
        o.x = Q8(s[0 * 33]) | (Q8(s[1 * 33]) << 8) | (Q8(s[2 * 33]) << 16) | (Q8(s[3 * 33]) << 24); o.y = Q8(s[4 * 33]) | (Q8(s[5 * 33]) << 8) | (Q8(s[6 * 33]) << 16) | (Q8(s[7 * 33]) << 24);
#undef Q8
        *(GAS v2u*)(WT + (size_t)(dst_row0 + n0 + n) * K + k0 + 8 * c) = o; }
    LDS_WAIT(); asm volatile("" ::: "memory");
}
__device__ __forceinline__ void rms_row_to_fp8(const float* xrow, const float* g, unsigned char* orow, int lane) {
    const GAS f32x4* xr = (const GAS f32x4*)xrow + lane; const GAS f32x4* gr = (const GAS f32x4*)g + lane;
    f32x4 v[8]; float s = 0.f;
#pragma unroll
    for (int j = 0; j < 8; ++j) { v[j] = xr[64 * j]; s += (v[j].x * v[j].x + v[j].y * v[j].y) + (v[j].z * v[j].z + v[j].w * v[j].w); }
    const float r = 1.0f / sqrtf(wave_sum(s) * (1.f / 2048.f) + EPS);
    GAS unsigned* o4 = (GAS unsigned*)orow + lane;
#pragma unroll
    for (int j = 0; j < 8; ++j) { const f32x4 gg = gr[64 * j]; o4[64 * j] = pk4_fp8(v[j].x * r * gg.x, v[j].y * r * gg.y, v[j].z * r * gg.z, v[j].w * r * gg.w); }
}
__device__ __forceinline__ void rms_row_to_bf16(const float* xrow, const float* g, bf16* orow, int lane) {
    const GAS f32x4* xr = (const GAS f32x4*)xrow + lane; const GAS f32x4* gr = (const GAS f32x4*)g + lane;
    f32x4 v[8]; float s = 0.f;
#pragma unroll
    for (int j = 0; j < 8; ++j) { v[j] = xr[64 * j]; s += (v[j].x * v[j].x + v[j].y * v[j].y) + (v[j].z * v[j].z + v[j].w * v[j].w); }
    const float r = 1.0f / sqrtf(wave_sum(s) * (1.f / 2048.f) + EPS);
    GAS v2u* o8 = (GAS v2u*)orow + lane;
#pragma unroll
    for (int j = 0; j < 8; ++j) { const f32x4 gg = gr[64 * j]; v2u o; o.x = pk2(v[j].x * r * gg.x, v[j].y * r * gg.y); o.y = pk2(v[j].z * r * gg.z, v[j].w * r * gg.w); o8[64 * j] = o; }
}
__device__ __forceinline__ float row_to_bf16_ss(const float* xrow, bf16* orow, unsigned char* qrow, int lane) {
    const GAS f32x4* xr = (const GAS f32x4*)xrow + lane; GAS v2u* o8 = (GAS v2u*)orow + lane; GAS unsigned* q4 = (GAS unsigned*)qrow + lane; float s = 0.f;
#pragma unroll
    for (int j = 0; j < 8; ++j) { const f32x4 v = xr[64 * j]; s += (v.x * v.x + v.y * v.y) + (v.z * v.z + v.w * v.w); v2u o; o.x = pk2(v.x, v.y); o.y = pk2(v.z, v.w); o8[64 * j] = o; q4[64 * j] = pg8::q8x4(v); }
    return wave_sum(s);
}
template <int NP  >
__device__ __forceinline__ void requant_row(bf16* xrow, const float* rmp, float* rs, int lane) {
    const GAS v4u* xr = (const GAS v4u*)xrow + lane;
    v4u v[4];
#pragma unroll
    for (int j = 0; j < 4; ++j) v[j] = xr[64 * j];
    float mxv = lane < NP ? rmp[lane] : 0.f;
#pragma unroll
    for (int o = 1; o < NP; o <<= 1) mxv = fmaxf(mxv, __shfl_xor(mxv, o));
    mxv = __builtin_amdgcn_readfirstlane(__float_as_uint(mxv)) ? __uint_as_float(__builtin_amdgcn_readfirstlane(__float_as_uint(mxv))) : 0.f;
    const float q = mxv > 0.f ? 127.0f / mxv : 0.f;
    asm volatile("s_waitcnt vmcnt(0)" ::: "memory");
    GAS v2u* o8 = (GAS v2u*)xrow + lane;
#pragma unroll
    for (int j = 0; j < 4; ++j) {
#define RQ(u_, sh_) ((unsigned)((int)__builtin_rintf(fminf(fmaxf(__uint_as_float(((u_) >> (sh_)) << 16) * q, -127.f), 127.f)) & 255))
        v2u o; o.x = RQ(v[j].x, 0) | (RQ(v[j].x, 16) << 8) | (RQ(v[j].y, 0) << 16) | (RQ(v[j].y, 16) << 24); o.y = RQ(v[j].z, 0) | (RQ(v[j].z, 16) << 8) | (RQ(v[j].w, 0) << 16) | (RQ(v[j].w, 16) << 24);
#undef RQ
        o8[64 * j] = o; }
    if (lane == 0) *rs = mxv * (1.0f / 127.0f);
}
__device__ __forceinline__ void requant_row_gate(bf16* xrow, const unsigned char* grow, float* rs, int lane) {
    const GAS v4u* xr = (const GAS v4u*)xrow + lane; const GAS v2u* gr = (const GAS v2u*)grow + lane;
    v4u v[4]; v2u g[4];
#pragma unroll
    for (int j = 0; j < 4; ++j) { v[j] = __builtin_nontemporal_load(xr + 64 * j); g[j] = __builtin_nontemporal_load(gr + 64 * j); }
    asm volatile("s_waitcnt vmcnt(0)" ::: "memory");
    float f[4][8]; float mxv = 0.f;
#pragma unroll
    for (int j = 0; j < 4; ++j) {
#define GB(w_, i_) ((float)((int)((w_) << (24 - 8 * (i_))) >> 24) * 0.0625f)
        f[j][0] = __uint_as_float(v[j].x << 16) * GB(g[j].x, 0); f[j][1] = __uint_as_float(v[j].x & 0xffff0000u) * GB(g[j].x, 1); f[j][2] = __uint_as_float(v[j].y << 16) * GB(g[j].x, 2); f[j][3] = __uint_as_float(v[j].y & 0xffff0000u) * GB(g[j].x, 3);
        f[j][4] = __uint_as_float(v[j].z << 16) * GB(g[j].y, 0); f[j][5] = __uint_as_float(v[j].z & 0xffff0000u) * GB(g[j].y, 1); f[j][6] = __uint_as_float(v[j].w << 16) * GB(g[j].y, 2); f[j][7] = __uint_as_float(v[j].w & 0xffff0000u) * GB(g[j].y, 3);
#undef GB
#pragma unroll
        for (int e = 0; e < 8; ++e) mxv = fmaxf(mxv, fabsf(f[j][e])); }
#pragma unroll
    for (int o = 1; o < 64; o <<= 1) mxv = fmaxf(mxv, __shfl_xor(mxv, o));
    const float q = mxv > 0.f ? 127.0f / mxv : 0.f;
    GAS v2u* o8 = (GAS v2u*)xrow + lane;
#pragma unroll
    for (int j = 0; j < 4; ++j) {
#define RQ(x_) ((unsigned)((int)__builtin_rintf((x_) * q) & 255))
        v2u o; o.x = RQ(f[j][0]) | (RQ(f[j][1]) << 8) | (RQ(f[j][2]) << 16) | (RQ(f[j][3]) << 24); o.y = RQ(f[j][4]) | (RQ(f[j][5]) << 8) | (RQ(f[j][6]) << 16) | (RQ(f[j][7]) << 24);
#undef RQ
        o8[64 * j] = o; }
    if (lane == 0) *rs = mxv * (1.0f / 127.0f);
}
__device__ __forceinline__ void rms_row_final(const bf16* xrow, const float* ssp, float* orow, const float* g, int lane) {
    const f32x4 s0 = *(const f32x4*)ssp, s1 = *(const f32x4*)(ssp + 4);
    const float r = 1.0f / sqrtf((((s0[0] + s0[1]) + (s0[2] + s0[3])) + ((s1[0] + s1[1]) + (s1[2] + s1[3]))) * (1.f / 2048.f) + EPS);
    const GAS v4u* xr = (const GAS v4u*)xrow + lane; GAS f32x4* orr = (GAS f32x4*)orow + 2 * lane; const GAS f32x4* gr = (const GAS f32x4*)g + 2 * lane;
#pragma unroll
    for (int j = 0; j < 4; ++j) { const v4u v = xr[64 * j]; const f32x4 g0 = gr[128 * j], g1 = gr[128 * j + 1];
        orr[128 * j] = (f32x4){__uint_as_float(v.x << 16) * r * g0.x, __uint_as_float(v.x & 0xffff0000u) * r * g0.y, __uint_as_float(v.y << 16) * r * g0.z, __uint_as_float(v.y & 0xffff0000u) * r * g0.w};
        orr[128 * j + 1] = (f32x4){__uint_as_float(v.z << 16) * r * g1.x, __uint_as_float(v.z & 0xffff0000u) * r * g1.y, __uint_as_float(v.w << 16) * r * g1.z, __uint_as_float(v.w & 0xffff0000u) * r * g1.w}; }
}
__device__ __forceinline__ void rms_row_f32(const float* xrow, float* orow, const float* g, int lane) {
    const GAS f32x4* xr = (const GAS f32x4*)xrow + lane; GAS f32x4* orr = (GAS f32x4*)orow + lane; const GAS f32x4* gr = (const GAS f32x4*)g + lane;
    f32x4 v[8]; float s = 0.f;
#pragma unroll
    for (int j = 0; j < 8; ++j) { v[j] = xr[64 * j]; s += (v[j].x * v[j].x + v[j].y * v[j].y) + (v[j].z * v[j].z + v[j].w * v[j].w); }
    const float r = 1.0f / sqrtf(wave_sum(s) * (1.f / 2048.f) + EPS);
#pragma unroll
    for (int j = 0; j < 8; ++j) { const f32x4 gg = gr[64 * j]; orr[64 * j] = (f32x4){v[j].x * r * gg.x, v[j].y * r * gg.y, v[j].z * r * gg.z, v[j].w * r * gg.w}; }
}
__device__ __forceinline__ void cq_row(const float* raw, const float* qn, const float* kn, bf16* cq, bf16* ckv, int lane) {
    const GAS f32x4* xr = (const GAS f32x4*)raw + lane;
    const f32x4 a0 = xr[0], a1 = xr[64], c0 = xr[128];
    const float sq = wave_sum((a0.x * a0.x + a0.y * a0.y) + (a0.z * a0.z + a0.w * a0.w) + (a1.x * a1.x + a1.y * a1.y) + (a1.z * a1.z + a1.w * a1.w));
    const float sk = wave_sum((c0.x * c0.x + c0.y * c0.y) + (c0.z * c0.z + c0.w * c0.w));
    const float rq = 1.0f / sqrtf(sq * (1.f / 512.f) + EPS), rk = 1.0f / sqrtf(sk * (1.f / 256.f) + EPS);
    const f32x4 g0 = ((const GAS f32x4*)qn)[lane], g1 = ((const GAS f32x4*)qn)[lane + 64], gk = ((const GAS f32x4*)kn)[lane];
    v2u o; o.x = pk2(a0.x * rq * g0.x, a0.y * rq * g0.y); o.y = pk2(a0.z * rq * g0.z, a0.w * rq * g0.w); ((GAS v2u*)cq)[lane] = o;
    o.x = pk2(a1.x * rq * g1.x, a1.y * rq * g1.y); o.y = pk2(a1.z * rq * g1.z, a1.w * rq * g1.w); ((GAS v2u*)cq)[lane + 64] = o;
    o.x = pk2(c0.x * rk * gk.x, c0.y * rk * gk.y); o.y = pk2(c0.z * rk * gk.z, c0.w * rk * gk.w); ((GAS v2u*)ckv)[lane] = o;
}

__device__ __forceinline__ void fpre_stage(LAS unsigned char* wl, const unsigned char* W8, int tid) {
    typedef int v4i32_ __attribute__((ext_vector_type(4)));
#pragma unroll
    for (int q = 0; q < 4; ++q) { const int idx = q * 512 + tid, row = idx >> 7, ch = idx & 127; *(LAS v4i32_*)(wl + row * 2064 + ch * 16) = *(const GAS v4i32_*)(W8 + (size_t)idx * 16); }
}
__device__ __forceinline__ void fpre_rows(const LAS unsigned char* wl, const unsigned char* A8, const float* SS, const float* CS, const float* fbias, float* LF, int row0, int lane, bool first) {
    typedef int v4i32_ __attribute__((ext_vector_type(4)));
    const int i = lane & 15, g = lane >> 4;
    const unsigned char* ap = A8 + (size_t)(row0 + i) * 2048 + 16 * g;
    v4i32_ af[32];
#pragma unroll
    for (int s = 0; s < 32; ++s) af[s] = *(const GAS v4i32_*)(ap + 64 * s);
    f32x4 ss[4][2];
#pragma unroll
    for (int e = 0; e < 4; ++e) { const f32x4* sp = (const f32x4*)(SS + (size_t)(row0 + 4 * g + e) * 8); ss[e][0] = sp[0]; ss[e][1] = sp[1]; }
    const float cs = CS[i], fb = fbias[i];
    if (first) __syncthreads();
    const LAS unsigned char* bp = wl + i * 2064 + 16 * g;
    v4i32_ acc = (v4i32_){0, 0, 0, 0};
#pragma unroll
    for (int s = 0; s < 32; ++s) acc = __builtin_amdgcn_mfma_i32_16x16x64_i8(af[s], *(const LAS v4i32_*)(bp + 64 * s), acc, 0, 0, 0);
#pragma unroll
    for (int e = 0; e < 4; ++e) {
        const f32x4 s0 = ss[e][0], s1 = ss[e][1];
        const float rf = __builtin_amdgcn_rsqf(((((s0[0] + s0[1]) + (s0[2] + s0[3])) + ((s1[0] + s1[1]) + (s1[2] + s1[3])))) * (1.0f / 2048.0f) + 1e-6f);
        const float x = (float)acc[e] * (cs * rf) + fb;
        LF[(size_t)(row0 + 4 * g + e) * 16 + i] = fminf(x, 0.f) - __logf(1.0f + __expf(-fabsf(x)));
    }
}

__device__ __forceinline__ unsigned ord_key(float f) { const unsigned u = __float_as_uint(f); return u ^ ((unsigned)((int)u >> 31) | 0x80000000u); }
__device__ __forceinline__ int mbcnt64(unsigned long long m) { return __builtin_amdgcn_mbcnt_hi((unsigned)(m >> 32), __builtin_amdgcn_mbcnt_lo((unsigned)m, 0u)); }
__device__ __forceinline__ unsigned long long cmp_ge_mask(unsigned key, unsigned cand) { unsigned long long m; asm("v_cmp_ge_u32_e64 %0, %1, %2" : "=s"(m) : "v"(key), "s"(cand)); return m; }
__device__ __forceinline__ unsigned long long cmp_lt_mask(unsigned a, unsigned b) { unsigned long long m; asm("v_cmp_lt_u32_e64 %0, %1, %2" : "=s"(m) : "v"(a), "s"(b)); return m; }
__device__ __forceinline__ int sel_pos(unsigned long long m, int base, int dump) { const int p = base + mbcnt64(m); int r; asm("v_cndmask_b32_e64 %0, %1, %2, %3" : "=v"(r) : "v"(dump), "v"(p), "s"(m)); return r; }
template <int NV>
__device__ __forceinline__ void topk_select(const LAS unsigned* sc, int t, int lane, int* out, unsigned& gpre  ) {
    { int l_ = lane; asm volatile("" : "+v"(l_)); lane = l_; }
    unsigned key[NV];
    const int tl = t - lane;
#pragma unroll
    for (int i = 0; i < NV; ++i) { const unsigned v = sc[i * 64 + lane]; key[i] = (tl >= i * 64) ? v : 0u; }
    unsigned T = 0u;
    constexpr int NC = 8;
    int cntT = 64 * NV, nabove = 0, bit = 31; bool done = false;
#define TS_COUNT(cnt_, cand_) do { cnt_ = 0; \
        _Pragma("unroll") for (int i0 = 0; i0 < NV; i0 += 8) { unsigned long long mk[8]; \
            _Pragma("unroll") for (int j = 0; j < 8; ++j) mk[j] = cmp_ge_mask(key[i0 + j], cand_); \
            __builtin_amdgcn_sched_barrier(0); \
            _Pragma("unroll") for (int j = 0; j < 8; ++j) cnt_ += __builtin_popcountll(mk[j]); \
            __builtin_amdgcn_sched_barrier(0); } } while (0)
    if (gpre != 0u && gpre < 0xff000000u) {
        unsigned g = gpre; int c0, c1;
        TS_COUNT(c0, g);
        if (c0 >= TOPK) { const unsigned g1 = g + (1u << 23); TS_COUNT(c1, g1); if (c1 >= TOPK && g1 < 0xff000000u) { g = g1; c0 = c1; const unsigned g2 = g1 + (1u << 23); TS_COUNT(c1, g2); } }
        else if (g >= (2u << 23)) { c1 = c0; g -= (1u << 23); TS_COUNT(c0, g); }
        else { c1 = TOPK; }
        if (c0 >= TOPK && c1 < TOPK) { T = g; cntT = c0; nabove = c1; bit = 22; done = c0 == TOPK; }
    }
    for (; !done && bit >= 0; --bit) {
        const unsigned cand = T | (1u << bit); int cnt;
        TS_COUNT(cnt, cand);
        if (cnt >= TOPK) { T = cand; cntT = cnt; if (cnt == TOPK) { done = true; break; } } else nabove = cnt;
        if (NV > NC && bit >= 6 && cntT - nabove <= 64 * NC) { --bit; break; }
    }
    if (NV > NC && !done && bit >= 0) {
        LAS unsigned* lst = (LAS unsigned*)sc;
        const unsigned width = 2u << bit; int base = 0;
#pragma unroll
        for (int i0 = 0; i0 < NV; i0 += 8) {
            unsigned long long mk[8];
#pragma unroll
            for (int j = 0; j < 8; ++j) mk[j] = cmp_lt_mask(key[i0 + j] - T, width);
            __builtin_amdgcn_sched_barrier(0);
#pragma unroll
            for (int j = 0; j < 8; ++j) { lst[sel_pos(mk[j], base, 1024 + lane)] = key[i0 + j]; base += __builtin_popcountll(mk[j]); }
            __builtin_amdgcn_sched_barrier(0);
        }
        unsigned ck[NC];
#pragma unroll
        for (int i = 0; i < NC; ++i) { const unsigned v = lst[i * 64 + lane]; ck[i] = (i * 64 + lane < base) ? v : 0u; }
        const int need = TOPK - nabove;
        for (; bit >= 0; --bit) {
            const unsigned cand = T | (1u << bit); int cnt = 0;
            unsigned long long mk[NC];
#pragma unroll
            for (int i = 0; i < NC; ++i) mk[i] = cmp_ge_mask(ck[i], cand);
            __builtin_amdgcn_sched_barrier(0);
#pragma unroll
            for (int i = 0; i < NC; ++i) cnt += __builtin_popcountll(mk[i]);
            if (cnt >= need) { T = cand; if (cnt == need) { done = true; break; } }
        }
    }
    gpre = T & 0xff800000u;
#undef TS_COUNT
    LAS int* ol = (LAS int*)sc + 2048;
    int base = 0;
    if (done) {
#pragma unroll
        for (int i0 = 0; i0 < NV; i0 += 8) {
            unsigned long long mk[8];
#pragma unroll
            for (int j = 0; j < 8; ++j) mk[j] = cmp_ge_mask(key[i0 + j], T);
            __builtin_amdgcn_sched_barrier(0);
#pragma unroll
            for (int j = 0; j < 8; ++j) { ol[sel_pos(mk[j], base, TOPK + lane)] = (i0 + j) * 64 + lane; base += __builtin_popcountll(mk[j]); }
            __builtin_amdgcn_sched_barrier(0);
        }
    } else {
#pragma unroll
    for (int i = 0; i < NV; ++i) {
        const bool gt = key[i] > T; const unsigned long long m = __ballot(gt);
        if (gt) ol[base + mbcnt64(m)] = i * 64 + lane;
        base += __builtin_popcountll(m);
        if ((i & 3) == 3) __builtin_amdgcn_sched_barrier(0);
    }
#pragma unroll
    for (int i = 0; i < NV; ++i) {
        const bool eq = key[i] == T; const unsigned long long m = __ballot(eq);
        const int pos = base + mbcnt64(m);
        if (eq && pos < TOPK) ol[pos] = i * 64 + lane;
        base += __builtin_popcountll(m);
        if ((i & 3) == 3) __builtin_amdgcn_sched_barrier(0);
    }
    }
    const v4i r4 = ((const LAS v4i*)ol)[lane];
    *(v4i*)(out + 4 * lane) = r4;
}
__device__ __forceinline__ void topk_phase(LAS unsigned char* lds, const bf16* QI, const bf16* IK, const float* IW, int* IDX, int G, int bid, int wave, int lane, const int mode  ) {
    LAS unsigned* sc = (LAS unsigned*)lds;
    const int i31 = lane & 31, kh = lane >> 5;
    const int headA = (i31 & 3) + 4 * (i31 >> 3), qsel = (i31 >> 2) & 1;
    const int mh = wave >> 2, kw = wave & 3;
    bf16x8 a[2][4]; f32x4 w[2][4];
#define TK_LOAD_AW(it_) do { const size_t r0_ = (size_t)((it_) & 7) * SEQ + (size_t)((it_) >> 3) * 8; \
        _Pragma("unroll") for (int m = 0; m < 2; ++m) { \
            _Pragma("unroll") for (int s = 0; s < 4; ++s) a[m][s] = *(const bf16x8*)(QI + (r0_ + 4 * mh + 2 * m + qsel) * NQI + 4096 + headA * 64 + 16 * s + 8 * kh); \
            _Pragma("unroll") for (int g4 = 0; g4 < 4; ++g4) w[m][g4] = *(const f32x4*)(IW + (r0_ + 4 * mh + 2 * m + kh) * 16 + 4 * g4); } } while (0)
    unsigned gpre = 0u;
    if (bid < M / 8) TK_LOAD_AW(bid);
    for (int item = bid; item < M / 8; item += G) {
        const int b = item & 7, t0 = (item >> 3) * 8; const size_t row0 = (size_t)b * SEQ + t0;
        if ((mode & 1) && t0 + 8 > TOPK) {
            const int ntiles = (t0 + 8 + 31) >> 5;
            const int nti = (ntiles - kw + 3) >> 2;
            const bf16* ikb = IK + (size_t)b * SEQ * 64 + (size_t)lane * 8;
#define TK_LOAD(dst, i_) do { int kt_ = kw + 4 * (i_); kt_ = kt_ < ntiles ? kt_ : ntiles - 1; \
                _Pragma("unroll") for (int s = 0; s < 4; ++s) dst[s] = *(const bf16x8*)(ikb + (size_t)kt_ * 2048 + 512 * s); } while (0)
#define TK_COMP(src, i_) do { const int kt_ = kw + 4 * (i_); if (kt_ < ntiles) { \
                _Pragma("unroll") for (int m = 0; m < 2; ++m) { f32x16 acc = {}; \
                    _Pragma("unroll") for (int s = 0; s < 4; ++s) acc = __builtin_amdgcn_mfma_f32_32x32x16_bf16(a[m][s], src[s], acc, 0, 0, 0); \
                    float sv = 0.f; \
                    _Pragma("unroll") for (int r = 0; r < 16; ++r) { const int ai_ = __float_as_int(acc[r]); sv = fmaf(__int_as_float(ai_ > 0 ? ai_ : 0), w[m][r >> 2][r & 3], sv); }     \
                    sc[(4 * mh + 2 * m + kh) * 4096 + kt_ * 32 + i31] = ord_key(sv); } } } while (0)
            bf16x8 b0[4], b1[4], b2[4], b3[4];
            TK_LOAD(b0, 0); TK_LOAD(b1, 1); TK_LOAD(b2, 2);
            for (int i = 0; i < nti; i += 4) {
                TK_LOAD(b3, i + 3); TK_COMP(b0, i);
                TK_LOAD(b0, i + 4); TK_COMP(b1, i + 1);
                TK_LOAD(b1, i + 5); TK_COMP(b2, i + 2);
                TK_LOAD(b2, i + 6); TK_COMP(b3, i + 3);
            }
#undef TK_LOAD
#undef TK_COMP
        }
        if (item + G < M / 8) TK_LOAD_AW(item + G);
        __syncthreads();
        if (mode & 2) {
            const int t = t0 + wave; int* out = IDX + (row0 + wave) * TOPK; const LAS unsigned* scq = sc + wave * 4096;
            if (t < TOPK) {
#pragma unroll
                for (int i = 0; i < 4; ++i) { const int s = i * 64 + lane; out[s] = s <= t ? s : 0; }
            } else if (t0 + 8 <= 512) topk_select<8>(scq, t, lane, out, gpre);
            else if (t0 + 8 <= 1024) topk_select<16>(scq, t, lane, out, gpre);
            else if (t0 + 8 <= 1536) topk_select<24>(scq, t, lane, out, gpre);
            else if (t0 + 8 <= 2048) topk_select<32>(scq, t, lane, out, gpre);
            else if (t0 + 8 <= 2560) topk_select<40>(scq, t, lane, out, gpre);
            else if (t0 + 8 <= 3072) topk_select<48>(scq, t, lane, out, gpre);
            else if (t0 + 8 <= 3584) topk_select<56>(scq, t, lane, out, gpre);
            else topk_select<64>(scq, t, lane, out, gpre);
        }
        __syncthreads();
    }
#undef TK_LOAD_AW
}

__device__ __forceinline__ int t5_bucket(int d) {
    if (d < 16) return d;
    const float v = logf((float)d / 16.0f) / 2.0794415416798357f * 16.0f;
    int l = 16 + (int)v; return l < 31 ? l : 31;
}
__device__ __forceinline__ s16x4 tr_read(const LAS unsigned char* p) { return __builtin_bit_cast(s16x4, __builtin_amdgcn_ds_read_tr16_b64_v4i16((LAS v4i16_t*)p)); }
__device__ __forceinline__ unsigned cvtpk(float lo, float hi) { unsigned r; asm volatile("v_cvt_pk_bf16_f32 %0, %1, %2" : "=v"(r) : "v"(lo), "v"(hi)); return r; }
__device__ __forceinline__ float xor16_max(float x) { const unsigned u = __float_as_uint(x); const auto r = __builtin_amdgcn_permlane16_swap(u, u, false, false); return fmaxf(__uint_as_float(r[0]), __uint_as_float(r[1])); }
__device__ __forceinline__ float xor32_max(float x) { const unsigned u = __float_as_uint(x); const auto r = __builtin_amdgcn_permlane32_swap(u, u, false, false); return fmaxf(__uint_as_float(r[0]), __uint_as_float(r[1])); }
__device__ __forceinline__ float xor16_sum(float x) { const unsigned u = __float_as_uint(x); const auto r = __builtin_amdgcn_permlane16_swap(u, u, false, false); return __uint_as_float(r[0]) + __uint_as_float(r[1]); }
__device__ __forceinline__ float xor32_sum(float x) { const unsigned u = __float_as_uint(x); const auto r = __builtin_amdgcn_permlane32_swap(u, u, false, false); return __uint_as_float(r[0]) + __uint_as_float(r[1]); }
__device__ __forceinline__ void sparse_phase(LAS unsigned char* lds, bf16* QI, const bf16* CKV, const int* IDX, const float* rel_bias, float* RSU  , int G, int bid, int wave, int lane, int tid, bf16* dummy  , const int mode  ) {
    LAS float* tab = (LAS float*)(lds + AUX_OFF);
    for (int e = tid; e < 129 * 16; e += NWAVES * 64) tab[e] = rel_bias[t5_bucket(e >> 4) * 16 + (e & 15)];
    __syncthreads();
    LAS unsigned char* buf = lds + RING_OFF + wave * 16384;
    LAS int* idl = (LAS int*)(lds + AUX_OFF + 8448) + wave * 256;
    const int h = lane & 15, kqo = lane >> 4;
    const int qstep = G * NWAVES;
    int q = bid * NWAVES + wave;
    bf16x8 qa[8]; v4i ivn = (v4i){0, 0, 0, 0};
#pragma unroll
    for (int s = 0; s < 8; ++s) qa[s] = (bf16x8){0, 0, 0, 0, 0, 0, 0, 0};
    if (q < M) {
#pragma unroll
        for (int s = 0; s < 8; ++s) qa[s] = __builtin_nontemporal_load((const bf16x8*)(QI + (size_t)q * NQI + h * 256 + 32 * s + 8 * kqo));
        ivn = __builtin_nontemporal_load((const v4i*)(IDX + (size_t)q * TOPK) + lane);
    }
    for (; q < M; q += qstep) {
        const int b = q >> 12, t = q & (SEQ - 1);
        const int nvalid = t + 1 < TOPK ? t + 1 : TOPK, nch = (nvalid + 31) >> 5;
        bf16* qrow = QI + (size_t)q * NQI;
        ((LAS v4i*)idl)[lane] = ivn;
        if (q + qstep < M) ivn = __builtin_nontemporal_load((const v4i*)(IDX + (size_t)(q + qstep) * TOPK) + lane);
        const bf16* ckvb = CKV + (size_t)b * SEQ * KVR;
        float m_run = -1e30f, l_part = 0.f;
        f32x4 o[16];
#pragma unroll
        for (int c = 0; c < 16; ++c) o[c] = (f32x4){0.f, 0.f, 0.f, 0.f};
#define SP_OFF(rv, j_) (((unsigned)(rv) << 9) + 16u * (unsigned)(l31_ ^ (((j_) & 7) << 1)))
#define SP_GATHER(ch_) do { int ln_ = lane; asm volatile("" : "+v"(ln_)); const int l31_ = ln_ & 31, lhi_ = ln_ >> 5; \
            const LAS v4i* il_ = (const LAS v4i*)(idl + (ch_) * 32 + 16 * lhi_); const v4i r0 = il_[0], r1 = il_[1], r2 = il_[2], r3 = il_[3]; unsigned keep_; \
            const unsigned o0 = SP_OFF(r0[0], 0), o1 = SP_OFF(r0[1], 1), o2 = SP_OFF(r0[2], 2), o3 = SP_OFF(r0[3], 3), o4 = SP_OFF(r1[0], 4), o5 = SP_OFF(r1[1], 5), o6 = SP_OFF(r1[2], 6), o7 = SP_OFF(r1[3], 7), \
                           o8 = SP_OFF(r2[0], 8), o9 = SP_OFF(r2[1], 9), o10 = SP_OFF(r2[2], 10), o11 = SP_OFF(r2[3], 11), o12 = SP_OFF(r3[0], 12), o13 = SP_OFF(r3[1], 13), o14 = SP_OFF(r3[2], 14), o15 = SP_OFF(r3[3], 15); \
            asm volatile("s_mov_b32 %0, m0\n\ts_mov_b32 m0, %1\n\ts_nop 0\n\t" \
                         "global_load_lds_dwordx4 %3, %2\n\ts_add_u32 m0, m0, 0x400\n\ts_nop 0\n\tglobal_load_lds_dwordx4 %4, %2\n\ts_add_u32 m0, m0, 0x400\n\ts_nop 0\n\t" \
                         "global_load_lds_dwordx4 %5, %2\n\ts_add_u32 m0, m0, 0x400\n\ts_nop 0\n\tglobal_load_lds_dwordx4 %6, %2\n\ts_add_u32 m0, m0, 0x400\n\ts_nop 0\n\t" \
                         "global_load_lds_dwordx4 %7, %2\n\ts_add_u32 m0, m0, 0x400\n\ts_nop 0\n\tglobal_load_lds_dwordx4 %8, %2\n\ts_add_u32 m0, m0, 0x400\n\ts_nop 0\n\t" \
                         "global_load_lds_dwordx4 %9, %2\n\ts_add_u32 m0, m0, 0x400\n\ts_nop 0\n\tglobal_load_lds_dwordx4 %10, %2\n\ts_add_u32 m0, m0, 0x400\n\ts_nop 0\n\t" \
                         "global_load_lds_dwordx4 %11, %2\n\ts_add_u32 m0, m0, 0x400\n\ts_nop 0\n\tglobal_load_lds_dwordx4 %12, %2\n\ts_add_u32 m0, m0, 0x400\n\ts_nop 0\n\t" \
                         "global_load_lds_dwordx4 %13, %2\n\ts_add_u32 m0, m0, 0x400\n\ts_nop 0\n\tglobal_load_lds_dwordx4 %14, %2\n\ts_add_u32 m0, m0, 0x400\n\ts_nop 0\n\t" \
                         "global_load_lds_dwordx4 %15, %2\n\ts_add_u32 m0, m0, 0x400\n\ts_nop 0\n\tglobal_load_lds_dwordx4 %16, %2\n\ts_add_u32 m0, m0, 0x400\n\ts_nop 0\n\t" \
                         "global_load_lds_dwordx4 %17, %2\n\ts_add_u32 m0, m0, 0x400\n\ts_nop 0\n\tglobal_load_lds_dwordx4 %18, %2\n\t" \
                         "s_mov_b32 m0, %0" \
                         : "=&s"(keep_) : "s"((unsigned)(size_t)buf), "s"(ckvb), "v"(o0), "v"(o1), "v"(o2), "v"(o3), "v"(o4), "v"(o5), "v"(o6), "v"(o7), "v"(o8), "v"(o9), "v"(o10), "v"(o11), "v"(o12), "v"(o13), "v"(o14), "v"(o15) \
                         : "memory", "scc"); } while (0)
        SP_GATHER(0);
        for (int ch = 0; ch < nch; ++ch) {
            int ln = lane; asm volatile("" : "+v"(ln) :: "memory");
            const int kq = ln >> 4, qq = (ln & 15) >> 2, p = ln & 3, xk = (ln & 7) << 1, key0 = 4 * kq + qq, k7 = key0 & 7, l15 = ln & 15;
            const v4i ki0 = *(const LAS v4i*)(idl + ch * 32 + 4 * kq), ki1 = *(const LAS v4i*)(idl + ch * 32 + 16 + 4 * kq);
            asm volatile("s_waitcnt vmcnt(0)" ::: "memory");
            bf16x8 Ar[2][8];
#pragma unroll
            for (int s = 0; s < 8; ++s) { const LAS unsigned char* ra = buf + l15 * 1024 + 16 * ((4 * s + kq) ^ xk); Ar[0][s] = *(const LAS bf16x8*)ra; Ar[1][s] = *(const LAS bf16x8*)(ra + 512); }
            __builtin_amdgcn_sched_barrier(0);
            f32x4 sa[2];
#pragma unroll
            for (int tt = 0; tt < 2; ++tt) {
                f32x4 acc = (f32x4){0.f, 0.f, 0.f, 0.f};
#pragma unroll
                for (int s = 0; s < 8; ++s) acc = __builtin_amdgcn_mfma_f32_16x16x32_bf16(Ar[tt][s], qa[s], acc, 0, 0, 0);
                sa[tt] = acc;
            }
            if (ch == nch - 1 && q + qstep < M) {
#pragma unroll
                for (int s = 0; s < 8; ++s) qa[s] = __builtin_nontemporal_load((const bf16x8*)(QI + (size_t)(q + qstep) * NQI + h * 256 + 32 * s + 8 * kqo));
            }
            s16x4 vlo[16], vhi[16];
#pragma unroll
            for (int c = 0; c < 16; ++c) { const LAS unsigned char* a0 = buf + key0 * 1024 + 32 * (c ^ k7) + 8 * p; vlo[c] = tr_read(a0); vhi[c] = tr_read(a0 + 512); }
            __builtin_amdgcn_sched_barrier(0);
            float lg[8]; float mx = -__builtin_inff();
#pragma unroll
            for (int e = 0; e < 4; ++e) {
                const int d0 = t - ki0[e], d1 = t - ki1[e];
                lg[e] = sa[0][e] + tab[(d0 < 128 ? d0 : 128) * 16 + h]; lg[4 + e] = sa[1][e] + tab[(d1 < 128 ? d1 : 128) * 16 + h];
            }
            if (ch * 32 + 32 > nvalid) {
#pragma unroll
                for (int e = 0; e < 4; ++e) { if (ch * 32 + 4 * kq + e >= nvalid) lg[e] = -__builtin_inff(); if (ch * 32 + 16 + 4 * kq + e >= nvalid) lg[4 + e] = -__builtin_inff(); }
            }
            __builtin_amdgcn_sched_barrier(0);
            asm volatile("s_waitcnt lgkmcnt(0)" ::: "memory");
            if (ch + 1 < nch) SP_GATHER(ch + 1);
            __builtin_amdgcn_sched_barrier(0);
#pragma unroll
            for (int e = 0; e < 8; ++e) mx = fmaxf(mx, lg[e]);
            mx = xor16_max(mx); mx = xor32_max(mx);
            if (!__all(mx - m_run <= 8.0f)) {
                const float mn = fmaxf(m_run, mx), alpha = __expf(m_run - mn);
                l_part *= alpha; m_run = mn;
#pragma unroll
                for (int c = 0; c < 16; ++c) o[c] = o[c] * alpha;
            }
            float pe[8], ps = 0.f;
#pragma unroll
            for (int e = 0; e < 8; ++e) { pe[e] = __expf(lg[e] - m_run); ps += pe[e]; }
            l_part += ps;
            v4u pw; pw.x = cvtpk(pe[0], pe[1]); pw.y = cvtpk(pe[2], pe[3]); pw.z = cvtpk(pe[4], pe[5]); asm volatile("v_cvt_pk_bf16_f32 %0, %1, %2\n\ts_nop 1" : "=v"(pw.w) : "v"(pe[6]), "v"(pe[7]));
            const bf16x8 P = __builtin_bit_cast(bf16x8, pw);
#pragma unroll
            for (int c = 0; c < 16; ++c) {
                const bf16x8 A = (bf16x8){vlo[c][0], vlo[c][1], vlo[c][2], vlo[c][3], vhi[c][0], vhi[c][1], vhi[c][2], vhi[c][3]};
                o[c] = __builtin_amdgcn_mfma_f32_16x16x32_bf16(A, P, o[c], 0, 0, 0);
            }
        }
#undef SP_GATHER
#undef SP_OFF
        float l = l_part; l = xor16_sum(l); l = xor32_sum(l);
        const float inv = 1.0f / l;
        float mx = 0.f;
#pragma unroll
        for (int c = 0; c < 16; ++c) { o[c] = o[c] * inv; mx = fmaxf(mx, fmaxf(fmaxf(fabsf(o[c][0]), fabsf(o[c][1])), fmaxf(fabsf(o[c][2]), fabsf(o[c][3])))); }
#pragma unroll
        for (int s = 1; s < 16; s <<= 1) mx = fmaxf(mx, __shfl_xor(mx, s));
        mx = xor16_max(mx); mx = xor32_max(mx);
        const float qs = mx > 0.f ? 127.0f / mx : 0.f;
#pragma unroll
        for (int c = 0; c < 16; ++c) {
            const f32x4 v = o[c] * qs;
            const unsigned w = (unsigned)((int)__builtin_rintf(v[0]) & 255) | ((unsigned)((int)__builtin_rintf(v[1]) & 255) << 8) | ((unsigned)((int)__builtin_rintf(v[2]) & 255) << 16) | ((unsigned)(int)__builtin_rintf(v[3]) << 24);
            *(LAS unsigned*)(buf + h * 256 + 16 * (c ^ h) + 4 * kqo) = w; }
        asm volatile("s_waitcnt lgkmcnt(0)" ::: "memory");
        { const int hr = lane >> 2, c0 = 4 * (lane & 3);
          unsigned char* orow = (dummy ? (unsigned char*)dummy + (size_t)(q & 16383) * 8192 : (unsigned char*)qrow) + 64 * lane;
#pragma unroll
          for (int i = 0; i < 4; ++i) { const v4u w = *(const LAS v4u*)(buf + hr * 256 + 16 * ((c0 + i) ^ hr)); *(v4u*)(orow + 16 * i) = w; } }
        if (lane == 0) RSU[q] = mx * (1.0f / 127.0f);
        asm volatile("s_waitcnt lgkmcnt(0)" ::: "memory");
    }
}

__device__ __forceinline__ void cumsum_phase(const float* LF, float* CB, LAS float* wsum  , int G, int bid, int wave, int lane) {
    for (int sq = bid; sq < BATCH * NH; sq += G) {
        const int b = sq >> 4, hh = sq & 15, s0 = wave * 512 + lane * 8;
        const float* src = LF + ((size_t)b * SEQ + s0) * 16 + hh;
        float v[8];
#pragma unroll
        for (int i = 0; i < 8; ++i) v[i] = src[(size_t)i * 16];
#pragma unroll
        for (int i = 1; i < 8; ++i) v[i] += v[i - 1];
        float inc = v[7];
#pragma unroll
        for (int o = 1; o < 64; o <<= 1) { const float n = __shfl_up(inc, o); if (lane >= o) inc += n; }
        if (lane == 63) wsum[wave] = inc;
        __syncthreads();
        float pre = 0.f;
        for (int w = 0; w < wave; ++w) pre += wsum[w];
        const float off = pre + (inc - v[7]);
        float* dst = CB + (size_t)sq * SEQ + s0;
        f32x4 o0, o1;
#pragma unroll
        for (int i = 0; i < 4; ++i) { o0[i] = __int_as_float((int)__builtin_rintf(-(off + v[i]) * (11.313708498984761f * 256.0f))); o1[i] = __int_as_float((int)__builtin_rintf(-(off + v[4 + i]) * (11.313708498984761f * 256.0f))); }
        *(f32x4*)dst = o0; *(f32x4*)(dst + 4) = o1;
        __syncthreads();
    }
}

struct Args { const float* in[15]; float* out; unsigned char* ws; int ph_lo, ph_hi; };
constexpr int PH_PRO = 0, PH_PRO2 = 1, PH_L0 = 2, PH_PER_LAYER = 12, PH_FINAL = PH_L0 + 2 * PH_PER_LAYER, PH_COUNT = PH_FINAL + 1;
#define KAS __attribute__((address_space(4)))
__device__ __forceinline__ int lane_id() { int l; asm volatile("v_mbcnt_lo_u32_b32 %0, -1, 0\n\tv_mbcnt_hi_u32_b32 %0, -1, %0" : "=v"(l)); return l; }
__device__ __forceinline__ bool ph_in(int k, int lo, int hi) { asm volatile("" : "+s"(lo), "+s"(hi)); return lo <= k && k < hi; }
__global__ void __launch_bounds__(NWAVES * 64, 2) trunk_fwd(Args args) {
    extern __shared__ __attribute__((aligned(16))) unsigned char lds_raw[];
    LAS unsigned char* lds = (LAS unsigned char*)lds_raw;
    const int wave0 = __builtin_amdgcn_readfirstlane((int)threadIdx.x >> 6);
    { const int tid = threadIdx.x;
      for (int u = tid; u < (LDS_BYTES - LDSCTL_OFF) / 4; u += NWAVES * 64) ((LAS unsigned*)(lds + LDSCTL_OFF))[u] = 0u; }
    __syncthreads();
    if (!MK_SPLIT) (void)xcd_barrier_post((unsigned*)((gu32*)(args.ws + WS_CTL) + CW_BAR), (volatile LAS unsigned*)(lds + MISC_OFF) + 8, threadIdx.x == 0);
#ifndef PH_MASK
#define PH_MASK 0xFFFFFFFFu
#endif
#ifndef PROBE_DUP
#define PROBE_DUP (-1)
#endif
#define REPS(k) ((PROBE_DUP) == (k) ? 2 : 1)
#ifndef PROBE_MODE
#define PROBE_MODE 3
#endif
#define PH_EN(k) (((PH_MASK) >> ((k) == PH_PRO ? 0 : (k) == PH_PRO2 ? 14 : (k) == PH_FINAL ? 13 : 1 + (((k) - PH_L0) % PH_PER_LAYER))) & 1u)
#define IN(k) (PH_EN(k) && ph_in((k), ((const KAS Args*)__builtin_amdgcn_kernarg_segment_ptr())->ph_lo, ((const KAS Args*)__builtin_amdgcn_kernarg_segment_ptr())->ph_hi))
#define PHASE_IDS() const KAS Args* ka = (const KAS Args*)__builtin_amdgcn_kernarg_segment_ptr(); asm volatile("" : "+s"(ka)); \
    int pwave = wave0; asm volatile("" : "+s"(pwave)); int plane = lane_id(); asm volatile("" : "+v"(plane)); int pbid = blockIdx.x; asm volatile("" : "+s"(pbid)); \
    const int ptid = pwave * 64 + plane, G = gridDim.x, NGW = G * NWAVES, pgw = pbid * NWAVES + pwave; unsigned char* const ws = ka->ws; float* const out = ka->out; \
    bf16* const XN = (bf16*)(ws + WS_XN); bf16* const GATE = (bf16*)(ws + WS_GATE); bf16* const R = (bf16*)out; (void)ptid; (void)NGW; (void)pgw; (void)XN; (void)GATE; (void)out; (void)R
#define SEAM(k) do { if (IN((k) + 1)) { XcdBarrier b2; b2.bar = (unsigned*)((gu32*)(ws + WS_CTL) + CW_BAR); b2.x = xb_xcc_id(); b2.st = (volatile LAS unsigned*)(lds + MISC_OFF) + 8; xcd_barrier(b2, ptid == 0); } } while (0)

    if (IN(PH_PRO)) {
        PHASE_IDS(); const int gw = pgw, lane = plane;
        _Pragma("unroll") for (int rep = 0; rep < REPS(13); ++rep) {
        LAS float* scr = (LAS float*)(lds + RING_OFF + pwave * 16384);
        constexpr int I1 = 32 * 32, I2 = 32 * 64, I3 = 8 * 32, I4 = 32 * 64, I5 = 32 * 192, I6 = 32 * 64, I7 = 32 * 8, I8 = 32 * 64, IPL = I1 + I2 + I3 + I4 + I5 + I6 + I7 + I8;
        for (int it = gw; it < 2 * IPL; it += NGW) {
            const int j = it / IPL; int r = it - j * IPL;
            unsigned char* wb = ws + WS_W + (size_t)j * W_LAYER;
            if (r < I1) { tr_item(ka->in[4] + (size_t)j * DM * A_IN, DM, A_IN, 0, 848, (bf16*)(wb + WO_A_IN), 0, 32, scr, r, lane, ka->in[1] + (size_t)(2 * j) * DM); continue; } r -= I1;
            if (r < I2) { colmax_item(ka->in[4] + (size_t)j * DM * A_IN, A_IN, 848, A_IN, (unsigned*)(ws + WS_CMAX + 131072) + (size_t)j * DI, 0, 64, r, lane, ka->in[1] + (size_t)(2 * j) * DM); continue; } r -= I2;
            if (r < I3) { tr_item(ka->in[10] + (size_t)j * QR * 1024, QR, 1024, 0, 1024, (bf16*)(wb + WO_A_Q), 4096, 32, scr, r, lane, ka->in[5] + (size_t)j * QR); continue; } r -= I3;
            if (r < I4) { colmax_item(ka->in[11] + (size_t)j * DI * DM, DM, 0, DM, (unsigned*)(ws + WS_CMAX + 147456) + (size_t)j * DM, 0, 64, r, lane, nullptr); continue; } r -= I4;
            unsigned* cmx = (unsigned*)(ws + WS_CMAX) + (size_t)j * NB_IN;
            if (r < I5) { colmax_item(ka->in[12] + (size_t)j * DM * B_IN, B_IN, 0, 6144, cmx, 0, 192, r, lane, ka->in[1] + (size_t)(2 * j + 1) * DM); continue; } r -= I5;
            if (r < I6) { colmax_item(ka->in[12] + (size_t)j * DM * B_IN, B_IN, 6160, B_IN, cmx, 6144, 64, r, lane, ka->in[1] + (size_t)(2 * j + 1) * DM); continue; } r -= I6;
            if (r < I7) { colmax_item(ka->in[12] + (size_t)j * DM * B_IN, B_IN, 6144, 6160, cmx, 8192, 8, r, lane, ka->in[1] + (size_t)(2 * j + 1) * DM); continue; } r -= I7;
            colmax_item(ka->in[14] + (size_t)j * DI * DM, DM, 0, DM, (unsigned*)(ws + WS_CMAX + 163840) + (size_t)j * DM, 0, 64, r, lane, nullptr);
        }
        for (int it = gw; it < 2 * 16 * 16 * 8; it += NGW) {
            const int j = it >> 11, hh = (it >> 7) & 15, rt = (it >> 3) & 15, cs = it & 7, l15 = lane & 15, kq = lane >> 4;
            const float* uk = ka->in[8] + (size_t)j * KVR * DI + (size_t)(rt * 16 + l15) * DI + hh * 128 + 8 * kq;
            const float* qu = ka->in[7] + (size_t)j * QR * DI + (size_t)(cs * 64 + l15) * DI + hh * 128 + 8 * kq;
            bf16x8 af[4];
#pragma unroll
            for (int s = 0; s < 4; ++s) { const f32x4 x0 = *(const GAS f32x4*)(uk + 32 * s), x1 = *(const GAS f32x4*)(uk + 32 * s + 4);
                v4u w; w.x = pk2(x0.x, x0.y); w.y = pk2(x0.z, x0.w); w.z = pk2(x1.x, x1.y); w.w = pk2(x1.z, x1.w); af[s] = __builtin_bit_cast(bf16x8, w); }
            bf16* wt = (bf16*)(ws + WS_W + (size_t)j * W_LAYER + WO_A_Q) + (size_t)(hh * 256 + rt * 16 + 4 * kq) * QR + cs * 64 + l15;
#pragma unroll
            for (int ct = 0; ct < 4; ++ct) {
                f32x4 acc = (f32x4){0.f, 0.f, 0.f, 0.f};
                const float gq = ka->in[5][(size_t)j * QR + cs * 64 + ct * 16 + l15];
#pragma unroll
                for (int s = 0; s < 4; ++s) { const float* qp = qu + (size_t)ct * 16 * DI + 32 * s; const f32x4 x0 = *(const GAS f32x4*)qp * gq, x1 = *(const GAS f32x4*)(qp + 4) * gq;
                    v4u w; w.x = pk2(x0.x, x0.y); w.y = pk2(x0.z, x0.w); w.z = pk2(x1.x, x1.y); w.w = pk2(x1.z, x1.w);
                    acc = __builtin_amdgcn_mfma_f32_16x16x32_bf16(af[s], __builtin_bit_cast(bf16x8, w), acc, 0, 0, 0); }
#pragma unroll
                for (int e = 0; e < 4; ++e) wt[(size_t)e * QR + ct * 16] = (bf16)f2bf(acc[e] * 0.08838834764831845f);
            }
        }
        for (int it = gw; it < 2 * 2048; it += NGW) {
            const int j = it >> 11, ng = it & 2047, n = ng & 255, hh = 2 * (ng >> 8) + (n >> 7), d = n & 127;
            const float* src = ka->in[9] + (size_t)j * KVR * DI + (size_t)(4 * lane) * DI + hh * 128 + d;
            const float w0 = src[0], w1 = src[DI], w2 = src[2 * DI], w3 = src[3 * DI];
            float mx = fmaxf(fmaxf(fabsf(w0), fabsf(w1)), fmaxf(fabsf(w2), fabsf(w3)));
#pragma unroll
            for (int s = 1; s < 64; s <<= 1) mx = fmaxf(mx, __shfl_xor(mx, s));
            const float qs = mx > 0.f ? 127.0f / mx : 0.f;
            unsigned char* row = ws + WS_W + (size_t)j * W_LAYER + WO_A_UV + (size_t)ng * 512;
            const unsigned wq = (unsigned)((int)__builtin_rintf(w0 * qs) & 255) | ((unsigned)((int)__builtin_rintf(w1 * qs) & 255) << 8) | ((unsigned)((int)__builtin_rintf(w2 * qs) & 255) << 16) | ((unsigned)(int)__builtin_rintf(w3 * qs) << 24);
            *(unsigned*)(row + (n >> 7) * 256 + 4 * lane) = wq; *(unsigned*)(row + ((n >> 7) ^ 1) * 256 + 4 * lane) = 0u;
            if (lane == 0) ((float*)(ws + WS_CSC + 180224))[(size_t)j * DI + ng] = mx * (1.0f / 127.0f);
        }
        for (int m = gw; m < M; m += NGW) { const float s = row_to_bf16_ss(ka->in[0] + (size_t)m * DM, R + (size_t)m * DM, ws + WS_H8 + (size_t)m * DM, lane); if (lane < 8) ((float*)(ws + WS_SS))[(size_t)m * 8 + lane] = lane == 0 ? s : 0.f; }
        }
        SEAM(PH_PRO);
    }
    if (IN(PH_PRO2)) {
        PHASE_IDS(); const int gw = pgw, lane = plane;
        LAS float* scr = (LAS float*)(lds + RING_OFF + pwave * 16384);
        constexpr int I2 = 32 * 64, I5 = 32 * 192, I6 = 32 * 64, I7 = 32 * 8, I4 = 32 * 64, I8 = 32 * 64, IPL = I2 + I5 + I6 + I7 + I4 + I8;
        for (int it = gw; it < 2 * IPL; it += NGW) {
            const int j = it / IPL; int r = it - j * IPL;
            if (r < I2) { tr_item_i8(ka->in[4] + (size_t)j * DM * A_IN, DM, A_IN, 848, A_IN, ws + WS_W + (size_t)j * W_LAYER + WO_A_IN + 4 * MiB, 0, 64, scr, r, lane, ka->in[1] + (size_t)(2 * j) * DM,
                                      (const unsigned*)(ws + WS_CMAX + 131072) + (size_t)j * DI, (float*)(ws + WS_CSC + 131072) + (size_t)j * DI, 1.0f / pg8::ACT_Q); continue; } r -= I2;
            unsigned char* wq = ws + WS_W + (size_t)j * W_LAYER + WO_B_IN; const unsigned* cmx = (const unsigned*)(ws + WS_CMAX) + (size_t)j * NB_IN; float* csc = (float*)(ws + WS_CSC) + (size_t)j * NB_IN;
            const float* W = ka->in[12] + (size_t)j * DM * B_IN; const float* gn = ka->in[1] + (size_t)(2 * j + 1) * DM;
            if (r < I5) { tr_item_i8(W, DM, B_IN, 0, 6144, wq, 0, 192, scr, r, lane, gn, cmx, csc, 1.0f / pg8::ACT_Q); continue; } r -= I5;
            if (r < I6) { tr_item_i8(W, DM, B_IN, 6160, B_IN, wq, 6144, 64, scr, r, lane, gn, cmx, csc, 1.0f / pg8::ACT_Q); continue; } r -= I6;
            if (r < I7) { tr_item_i8(W, DM, B_IN, 6144, 6160, wq, 8192, 8, scr, r, lane, gn, cmx, csc, 1.0f / pg8::ACT_Q); continue; } r -= I7;
            if (r < I4) { tr_item_i8(ka->in[11] + (size_t)j * DI * DM, DI, DM, 0, DM, ws + WS_W + (size_t)j * W_LAYER + WO_A_OUT, 0, 64, scr, r, lane, nullptr, (const unsigned*)(ws + WS_CMAX + 147456) + (size_t)j * DM, (float*)(ws + WS_CSC + 147456) + (size_t)j * DM, 1.0f); continue; } r -= I4;
            tr_item_i8(ka->in[14] + (size_t)j * DI * DM, DI, DM, 0, DM, ws + WS_W + (size_t)j * W_LAYER + WO_B_OUT, 0, 64, scr, r, lane, nullptr, (const unsigned*)(ws + WS_CMAX + 163840) + (size_t)j * DM, (float*)(ws + WS_CSC + 163840) + (size_t)j * DM, 1.0f);
        }
        SEAM(PH_PRO2);
#if defined(PROBE_XBAR)
        _Pragma("unroll") for (int xb = 0; xb < 16; ++xb) { SEAM(PH_PRO2); }
#endif
    }

    for (int j = 0; j < 2; ++j) {
        const int P = PH_L0 + j * PH_PER_LAYER;
        const size_t wbo = WS_W + (size_t)j * W_LAYER;
        if (IN(P + 0)) {
_Pragma("unroll") for (int rep = 0; rep < REPS(0); ++rep) { PHASE_IDS();
            { pg8::Gemm g{R, (const bf16*)(ws + wbo + WO_A_IN), M, 1024, DM, DM, 0}; pg8::StaticOrder S; S.init(M, 1024, G, pbid);
              pg8::EpiAIn E{(bf16*)(ws + WS_CQ), (bf16*)(ws + WS_CKV), (float*)(ws + WS_CQRAW), ka->in[6] + (size_t)j * KVR, (bf16*)(ws + WS_IK), (float*)(ws + WS_IW), (const float*)(ws + WS_SS) + (size_t)(2 * j) * M * 8, (LAS float*)(lds + AUX_OFF)};
              pg8::gemm_phase<pg8::EpiAIn, pg8::StaticOrder, true, true>(lds + RING_OFF, g, S, E, ptid); }
            { pg8::Gemm g{(const bf16*)(ws + WS_H8), (const bf16*)(ws + wbo + WO_A_IN + 4 * MiB), M, DI, DM / 2, DM / 2, 0}; pg8::StaticOrder S; S.init(M, DI, G, pbid);
              pg8::EpiAGate E{GATE, (const float*)(ws + WS_SS) + (size_t)(2 * j) * M * 8, (const float*)(ws + WS_CSC + 131072) + (size_t)j * DI};
              pg8::gemm_phase<pg8::EpiAGate, pg8::StaticOrder, true, true, 2>(lds + RING_OFF, g, S, E, ptid); }
            }
            { PHASE_IDS(); SEAM(P + 0); }
        }
        if (IN(P + 1)) {
_Pragma("unroll") for (int rep = 0; rep < REPS(1); ++rep) { PHASE_IDS();
            pg8::Gemm g{(const bf16*)(ws + WS_CQ), (const bf16*)(ws + wbo + WO_A_Q), M, NQI, QR, QR, 0}; pg8::StaticOrder S; S.init(M, NQI, G, pbid);
            pg8::EpiQ E{(bf16*)(ws + WS_QI), NQI, (const float*)(ws + WS_CQRAW)};
            pg8::gemm_phase<pg8::EpiQ, pg8::StaticOrder, true, true>(lds + RING_OFF, g, S, E, ptid);
            }
            { PHASE_IDS(); SEAM(P + 1); }
        }
        if (IN(P + 2)) {
_Pragma("unroll") for (int rep = 0; rep < REPS(2); ++rep) { PHASE_IDS();
            topk_phase(lds, (const bf16*)(ws + WS_QI), (const bf16*)(ws + WS_IK), (const float*)(ws + WS_IW), (int*)(ws + WS_IDX), G, pbid, pwave, plane, (REPS(2) == 2 && rep == 0) ? PROBE_MODE : 3);
            }
            { PHASE_IDS(); SEAM(P + 2); }
        }
        if (IN(P + 3)) {
_Pragma("unroll") for (int rep = 0; rep < REPS(3); ++rep) { PHASE_IDS();
            sparse_phase(lds, (bf16*)(ws + WS_QI), (const bf16*)(ws + WS_CKV), (const int*)(ws + WS_IDX), ka->in[3], (float*)(ws + WS_RS), G, pbid, pwave, plane, ptid, (REPS(3) == 2 && rep == 0) ? XN : nullptr, (REPS(3) == 2 && rep == 0) ? PROBE_MODE : 3);
            }
            { PHASE_IDS(); SEAM(P + 3); }
        }
        if (IN(P + 4)) {
_Pragma("unroll") for (int rep = 0; rep < REPS(4); ++rep) { PHASE_IDS();
            pg8::Gemm g{(const bf16*)(ws + WS_QI), (const bf16*)(ws + wbo + WO_A_UV), M, DI, 256, NQI, 256}; pg8::StaticOrder S; S.init(M, DI, G, pbid);
            pg8::EpiUV E{XN, (const float*)(ws + WS_RS), (const float*)(ws + WS_CSC + 180224) + (size_t)j * DI};
            pg8::gemm_phase<pg8::EpiUV, pg8::StaticOrder, true, true, 2>(lds + RING_OFF, g, S, E, ptid);
            }
            { PHASE_IDS(); SEAM(P + 4); }
        }
        if (IN(P + 5)) {
            { PHASE_IDS();
            for (int m = pgw; m < M; m += NGW) requant_row_gate(XN + (size_t)m * DM, (const unsigned char*)GATE + (size_t)m * DM, (float*)(ws + WS_RS) + m, plane);
            }
            { PHASE_IDS(); SEAM(P + 5); }
        }
        if (IN(P + 6)) {
{ PHASE_IDS();
            pg8::Gemm g{XN, (const bf16*)(ws + wbo + WO_A_OUT), M, DM, DI / 2, DI, 0}; pg8::StaticOrder S; S.init(M, DM, G, pbid);
            if (j == 0) { pg8::EpiRes<true> E{ka->in[0], (bf16*)nullptr, R, (unsigned char*)GATE, (float*)(ws + WS_SS) + (size_t)(2 * j + 1) * M * 8, (LAS float*)(lds + AUX_OFF), (const float*)(ws + WS_RS), (const float*)(ws + WS_CSC + 147456) + (size_t)j * DM};
              pg8::gemm_phase<pg8::EpiRes<true>, pg8::StaticOrder, true, true, 2>(lds + RING_OFF, g, S, E, ptid); }
            else { pg8::EpiRes<false> E{(const float*)nullptr, (bf16*)nullptr, R, (unsigned char*)GATE, (float*)(ws + WS_SS) + (size_t)(2 * j + 1) * M * 8, (LAS float*)(lds + AUX_OFF), (const float*)(ws + WS_RS), (const float*)(ws + WS_CSC + 147456) + (size_t)j * DM};
              pg8::gemm_phase<pg8::EpiRes<false>, pg8::StaticOrder, true, true, 2>(lds + RING_OFF, g, S, E, ptid); }
            }
            { PHASE_IDS(); SEAM(P + 6); }
        }
        if (IN(P + 7)) {
            { PHASE_IDS();
              LAS unsigned char* wl = (LAS unsigned char*)(lds + RING_OFF);
              fpre_stage(wl, ws + wbo + WO_B_IN + (size_t)8192 * 2048, ptid);
              bool first = true;
              for (int r0 = pgw * 16; r0 < M; r0 += NGW * 16, first = false)
                  fpre_rows(wl, (const unsigned char*)GATE, (const float*)(ws + WS_SS) + (size_t)(2 * j + 1) * M * 8, (const float*)(ws + WS_CSC) + (size_t)j * NB_IN + 8192, ka->in[13] + (size_t)j * NH, (float*)(ws + WS_LF), r0, plane, first);
              __syncthreads(); }
_Pragma("unroll") for (int rep = 0; rep < REPS(7); ++rep) { PHASE_IDS();
            pg8::Gemm g{GATE, (const bf16*)(ws + wbo + WO_B_IN), M, 8192, DM / 2, DM / 2, 0}; pg8::StaticOrder S; S.init(M, 8192, G, pbid);
            pg8::EpiBIn E{(bf16*)(ws + WS_Q), (size_t)(WS_K - WS_Q) / 2, XN, (float*)(ws + WS_LF), ka->in[13] + (size_t)j * NH, (const float*)(ws + WS_SS) + (size_t)(2 * j + 1) * M * 8, (const float*)(ws + WS_CSC) + (size_t)j * NB_IN};
            pg8::gemm_phase<pg8::EpiBIn, pg8::StaticOrder, true, true, 2>(lds + RING_OFF, g, S, E, ptid);
            }
            { PHASE_IDS(); SEAM(P + 7); }
        }
        if (IN(P + 8)) {
_Pragma("unroll") for (int rep = 0; rep < REPS(8); ++rep) { PHASE_IDS();
            cumsum_phase((const float*)(ws + WS_LF), (float*)(ws + WS_CB), (LAS float*)(lds + AUX_OFF), G, pbid, pwave, plane);
            }
            { PHASE_IDS(); SEAM(P + 8); }
        }
        if (IN(P + 9)) {
_Pragma("unroll") for (int rep = 0; rep < REPS(9); ++rep) { PHASE_IDS();
            const fox::Tensors T{ws + WS_Q, ws + WS_K, (const fox::bf16*)(ws + WS_V), (fox::bf16*)GATE, (const unsigned char*)XN, (const float*)(ws + WS_CB), (float*)(ws + WS_RMP)};
            fox::attn_phase((char*)lds_raw + RING_OFF, T, G, pbid, ptid);
            }
            { PHASE_IDS(); SEAM(P + 9); }
        }
        if (IN(P + 10)) {
            { PHASE_IDS();
            for (int m = pgw; m < M; m += NGW) requant_row_gate(GATE + (size_t)m * DM, (const unsigned char*)XN + (size_t)m * DM, (float*)(ws + WS_RS) + m, plane);
            }
            { PHASE_IDS(); SEAM(P + 10); }
        }
        if (IN(P + 11)) {
            { PHASE_IDS();
            pg8::Gemm g{GATE, (const bf16*)(ws + wbo + WO_B_OUT), M, DM, DI / 2, DI, 0}; pg8::StaticOrder S; S.init(M, DM, G, pbid);
            pg8::EpiRes<false> E{(const float*)nullptr, j == 1 ? (bf16*)(ws + WS_R) : (bf16*)nullptr, R, j == 0 ? ws + WS_H8 : (unsigned char*)nullptr, (float*)(ws + WS_SS) + (size_t)(j == 0 ? 2 : 0) * M * 8,     (LAS float*)(lds + AUX_OFF), (const float*)(ws + WS_RS), (const float*)(ws + WS_CSC + 163840) + (size_t)j * DM};
            pg8::gemm_phase<pg8::EpiRes<false>, pg8::StaticOrder, true, true, 2>(lds + RING_OFF, g, S, E, ptid);
            }
            { PHASE_IDS(); SEAM(P + 11); }
        }
    }
    if (IN(PH_FINAL)) {
        PHASE_IDS();
        for (int m = pgw; m < M; m += NGW) rms_row_final((const bf16*)(ws + WS_R) + (size_t)m * DM, (const float*)(ws + WS_SS) + (size_t)m * 8, out + (size_t)m * DM, ka->in[2], plane);
    }
#undef IN
#undef SEAM
}

extern "C" void kernel_launch(void* const* d_in, const int* in_sizes, int n_in, void* d_out, int out_size, void* d_ws, size_t ws_size, hipStream_t stream) {
    static int grid = 0;
    if (grid == 0) {
        if (n_in != 15 || in_sizes[0] != M * DM || out_size != M * DM || ws_size < WS_END) {
            fprintf(stderr, "kernel_launch: shape/workspace mismatch (n_in %d, in0 %d, out %d, ws %zu, need %zu); nothing launched\n", n_in, n_in > 0 ? in_sizes[0] : -1, out_size, ws_size, (size_t)WS_END); grid = -1; return; }
        int dev = 0, cus = 0, per_cu = 0;
        if (hipGetDevice(&dev) != hipSuccess || hipDeviceGetAttribute(&cus, hipDeviceAttributeMultiprocessorCount, dev) != hipSuccess) { grid = -1; return; }
        if (hipFuncSetAttribute((const void*)trunk_fwd, hipFuncAttributeMaxDynamicSharedMemorySize, LDS_BYTES) != hipSuccess) { fprintf(stderr, "kernel_launch: hipFuncSetAttribute failed\n"); grid = -1; return; }
        if (hipOccupancyMaxActiveBlocksPerMultiprocessor(&per_cu, (const void*)trunk_fwd, NWAVES * 64, LDS_BYTES) != hipSuccess || per_cu < 1)
            fprintf(stderr, "kernel_launch: note: occupancy query reports %d workgroups per CU\n", per_cu);
        (void)hipGetLastError();
        grid = cus;
    }
    if (grid < 0) return;
    if (hipMemsetAsync((char*)d_ws + WS_CTL, 0, CTL_ZERO_BYTES, stream) != hipSuccess) return;
    Args a{};
    for (int i = 0; i < 15; ++i) a.in[i] = (const float*)d_in[i];
    a.out = (float*)d_out; a.ws = (unsigned char*)d_ws;
#if MK_SPLIT
    for (int p = 0; p < PH_COUNT; ++p) { a.ph_lo = p; a.ph_hi = p + 1; hipLaunchKernelGGL(trunk_fwd, dim3(grid), dim3(NWAVES * 64), LDS_BYTES, stream, a); }
#else
    a.ph_lo = 0; a.ph_hi = PH_COUNT;
    hipLaunchKernelGGL(trunk_fwd, dim3(grid), dim3(NWAVES * 64), LDS_BYTES, stream, a);
#endif
    const hipError_t le = hipPeekAtLastError();
    if (le != hipSuccess) fprintf(stderr, "kernel_launch: launch failed: %s\n", hipGetErrorName(le));
}
```

```cpp
#include <hip/hip_runtime.h>
#include <hip/hip_bf16.h>
#include <cstdio>
#include <cstdint>

#ifndef MK_SPLIT
#define MK_SPLIT 0
#endif

constexpr int BATCH = 8, SEQ = 4096, DM = 2048, NH = 16, HD = 128, DI = 2048, QR = 512, KVR = 256, IDXH = 16, IDXD = 64, TOPK = 256;
constexpr int M = BATCH * SEQ;
constexpr int A_IN = QR + KVR + IDXD + IDXH + DI;
constexpr int B_IN = 3 * DI + NH + DI;
constexpr int NA_IN = 3072;
constexpr int NB_IN = 8448;
constexpr int NQI = 5120;
constexpr float EPS = 1e-6f;

constexpr size_t MiB = 1u << 20;
constexpr size_t WS_CTL = 0, CTL_ZERO_BYTES = 1 * MiB;
constexpr size_t WS_RS = 896 * 1024;
constexpr size_t WS_CMAX = 256 * 1024, WS_CSC = 512 * 1024;
constexpr size_t WS_W = 1 * MiB, W_LAYER = 68 * MiB;
constexpr size_t WO_A_IN = 0, WO_A_Q = 12 * MiB, WO_A_UV = 17 * MiB, WO_A_OUT = 19 * MiB, WO_B_IN = 27 * MiB, WO_B_OUT = 60 * MiB;
constexpr size_t WS_XN = 137 * MiB;
constexpr size_t WS_GATE = 265 * MiB;
constexpr size_t WS_R = 393 * MiB;
constexpr size_t WS_Q = WS_R, WS_K = WS_R + 128 * MiB, WS_V = WS_R + 256 * MiB, WS_LF = WS_R + 384 * MiB, WS_CB = WS_R + 386 * MiB;
constexpr size_t WS_CQRAW = WS_R, WS_CQ = WS_R + 96 * MiB, WS_CKV = WS_R + 128 * MiB, WS_IK = WS_R + 144 * MiB, WS_IW = WS_R + 148 * MiB,
                 WS_IDX = WS_R + 150 * MiB, WS_QI = WS_R + 182 * MiB;
constexpr size_t WS_SS = WS_QI + 320 * MiB;
constexpr size_t WS_H8 = WS_SS + 4 * MiB;
constexpr size_t WS_RMP = WS_H8 + 64 * MiB;
constexpr size_t WS_END = WS_RMP + 4 * MiB;
static_assert((size_t)M * 768 * 4 == 96 * MiB && (size_t)M * NQI * 2 == 320 * MiB && (size_t)NB_IN * 2048 * 2 == 33 * MiB && (size_t)NA_IN * 2048 * 2 == 12 * MiB, "d_ws map");


namespace pg8 {
#define PG8_LAS __attribute__((address_space(3)))
typedef unsigned short bf16_t;
typedef short bf16x8 __attribute__((ext_vector_type(8)));
typedef float f32x4 __attribute__((ext_vector_type(4)));
typedef unsigned u32x4 __attribute__((ext_vector_type(4)));
constexpr int BM = 256, BK = 64, HALF = 128, HTB = HALF * BK * 2  , STAGE_BYTES = 8 * HTB, NXCD = 8, WGM = 4;

__host__ __device__ __forceinline__ int lds_byte(int r, int c) { const int st = (r >> 4) * 2 + (c >> 5), rr = r & 15, cc = c & 31, ob = rr * 64 + cc * 2; return st * 1024 + (ob ^ (((ob >> 9) & 1) << 5)); }
__host__ __device__ __forceinline__ void stage_rc(int b, int& R, int& C) { const int st = b / 1024, sb = b % 1024, swz = sb ^ (((sb >> 9) & 1) << 5); R = (st >> 1) * 16 + swz / 64; C = (st & 1) * 32 + (swz % 64) / 2; }
__host__ __device__ __forceinline__ int perm32(int rho) { const int n = rho >> 4, i = rho & 15; return 8 * (i >> 2) + 4 * n + (i & 3); }

struct Unit { int pm, pn; };
struct Gemm { const bf16_t* A; const bf16_t* Bt; int M, N, K, lda, a_pn_off; };

struct StaticOrder {
    int nM, nN, nwg, G, c;
    __host__ __device__ void init(int M, int N, int G_, int c_) { nM = M / BM; nN = N / BM; nwg = nM * nN; G = G_; c = c_; }
    __host__ __device__ bool next(int i, Unit& u) const {
        const long L = (long)i * G + c; if (L >= nwg) return false;
        int wgid = (int)L; { const int q = nwg / NXCD, r = nwg % NXCD, xcd = wgid % NXCD, off = wgid / NXCD; wgid = (xcd < r ? xcd * (q + 1) : r * (q + 1) + (xcd - r) * q) + off; }
        const int nig = WGM * nN, gid = wgid / nig, fm = gid * WGM, gsz = (nM - fm) < WGM ? (nM - fm) : WGM;
        u.pm = fm + ((wgid % nig) % gsz); u.pn = (wgid % nig) / gsz; return true;
    }
    __device__ __forceinline__ void a_ready(const Unit&) const {}
    __device__ __forceinline__ void done(const Unit&) const {}
};


__device__ __forceinline__ unsigned cvt_pk_bf16(float lo, float hi) { unsigned r; asm volatile("v_cvt_pk_bf16_f32 %0, %1, %2" : "=v"(r) : "v"(lo), "v"(hi)); return r; }
typedef int v8i32 __attribute__((ext_vector_type(8)));
typedef int v4i32 __attribute__((ext_vector_type(4)));
__device__ __forceinline__ v8i32 cat8(const bf16x8 lo, const bf16x8 hi) { const v4i32 a = __builtin_bit_cast(v4i32, lo), b = __builtin_bit_cast(v4i32, hi); return __builtin_shufflevector(a, b, 0, 1, 2, 3, 4, 5, 6, 7); }
struct Frag2 { bf16x8 k[2]; };
template <int OPK> struct FragT;
template <> struct FragT<0> { typedef Frag2 type;
    static __device__ __forceinline__ void load(Frag2& d, const PG8_LAS unsigned char* p) { d.k[0] = *(const PG8_LAS bf16x8*)p; d.k[1] = *(const PG8_LAS bf16x8*)(p + 1024); }
    static __device__ __forceinline__ f32x4 mma(const Frag2& b, const Frag2& a, f32x4 c) { c = __builtin_amdgcn_mfma_f32_16x16x32_bf16(b.k[0], a.k[0], c, 0, 0, 0); return __builtin_amdgcn_mfma_f32_16x16x32_bf16(b.k[1], a.k[1], c, 0, 0, 0); } };
template <> struct FragT<1> { typedef v8i32 type;
    static __device__ __forceinline__ void load(v8i32& d, const PG8_LAS unsigned char* p) { const v4i32 lo = *(const PG8_LAS v4i32*)p, hi = *(const PG8_LAS v4i32*)(p + 1024); d = __builtin_shufflevector(lo, hi, 0, 1, 2, 3, 4, 5, 6, 7); }
    static __device__ __forceinline__ f32x4 mma(const v8i32& b, const v8i32& a, f32x4 c) { return __builtin_amdgcn_mfma_scale_f32_16x16x128_f8f6f4(b, a, c, 0, 0, 0, 0x79797979, 0, 0x7f7f7f7f); } };
__device__ __forceinline__ void epi_lane(int& fr, int& fq) { int l_; asm volatile("v_mbcnt_lo_u32_b32 %0, -1, 0\n\tv_mbcnt_hi_u32_b32 %0, -1, %0" : "=v"(l_)); fr = l_ & 15; fq = l_ >> 4; }
__device__ __forceinline__ float silu_f(float x) { return x * __builtin_amdgcn_rcpf(1.0f + __expf(-x)); }
__device__ __forceinline__ u32x4 pack8_bf16(const f32x4 v0, const f32x4 v1) { u32x4 w; w.x = cvt_pk_bf16(v0[0], v0[1]); w.y = cvt_pk_bf16(v0[2], v0[3]); w.z = cvt_pk_bf16(v1[0], v1[1]); w.w = cvt_pk_bf16(v1[2], v1[3]); return w; }
typedef unsigned u32x2_t __attribute__((ext_vector_type(2)));
__device__ __forceinline__ void st8x2_wide(unsigned char* rowp_self, int fq, u32x2_t A  , u32x2_t B  ) {
    const auto r0 = __builtin_amdgcn_permlane16_swap(A.x, B.x, false, false), r1 = __builtin_amdgcn_permlane16_swap(A.y, B.y, false, false);
    u32x4 w; w.x = r0[0]; w.y = r1[0]; w.z = r0[1]; w.w = r1[1];
    *(u32x4*)(rowp_self + ((fq & 1) ? HALF - 8 : 0)) = w;
}
__device__ __forceinline__ f32x4 silu4(const f32x4 v) { return (f32x4){silu_f(v[0]), silu_f(v[1]), silu_f(v[2]), silu_f(v[3])}; }
__device__ __forceinline__ float bf_lo(unsigned u) { return __uint_as_float(u << 16); }
__device__ __forceinline__ float bf_hi(unsigned u) { return __uint_as_float(u & 0xffff0000u); }

template <> struct FragT<2> { typedef Frag2 type;
    static __device__ __forceinline__ void load(Frag2& d, const PG8_LAS unsigned char* p) { d.k[0] = *(const PG8_LAS bf16x8*)p; d.k[1] = *(const PG8_LAS bf16x8*)(p + 1024); }
    static __device__ __forceinline__ f32x4 mma(const Frag2& b, const Frag2& a, f32x4 c) { v4i32 ci = __builtin_bit_cast(v4i32, c);
        ci = __builtin_amdgcn_mfma_i32_16x16x64_i8(__builtin_bit_cast(v4i32, b.k[0]), __builtin_bit_cast(v4i32, a.k[0]), ci, 0, 0, 0);
        ci = __builtin_amdgcn_mfma_i32_16x16x64_i8(__builtin_bit_cast(v4i32, b.k[1]), __builtin_bit_cast(v4i32, a.k[1]), ci, 0, 0, 0); return __builtin_bit_cast(f32x4, ci); } };
constexpr float ACT_Q = 16.0f;
__device__ __forceinline__ unsigned q8x4(const f32x4 v) {
    const int a = (int)__builtin_rintf(fminf(fmaxf(v[0] * ACT_Q, -127.f), 127.f)), b = (int)__builtin_rintf(fminf(fmaxf(v[1] * ACT_Q, -127.f), 127.f)),
              c = (int)__builtin_rintf(fminf(fmaxf(v[2] * ACT_Q, -127.f), 127.f)), d = (int)__builtin_rintf(fminf(fmaxf(v[3] * ACT_Q, -127.f), 127.f));
    return (unsigned)(a & 255) | ((unsigned)(b & 255) << 8) | ((unsigned)(c & 255) << 16) | ((unsigned)d << 24);
}
struct EpiBf16 {
    static constexpr bool PERM = true, AFTER_DRAIN = false;
    bf16_t* O; int ldc;
    __device__ __forceinline__ void operator()(const f32x4 (&acc)[2][2][4][2], const Unit& u, int wr, int wc, int fr, int fq) const {
        epi_lane(fr, fq);
        const int row0 = u.pm * BM + wr * 64 + fr, col0 = u.pn * BM + wc * 32 + 8 * fq;
#pragma unroll
        for (int ai = 0; ai < 2; ++ai)
#pragma unroll
            for (int m = 0; m < 4; ++m) { bf16_t* rowp = O + (size_t)(row0 + ai * HALF + m * 16) * ldc + col0;
#pragma unroll
                for (int bj = 0; bj < 2; ++bj) *(u32x4*)(rowp + bj * HALF) = pack8_bf16(acc[ai][bj][m][0], acc[ai][bj][m][1]); }
    }
};
struct EpiAIn {
    static constexpr bool PERM = true, AFTER_DRAIN = false;
    bf16_t* CQ; bf16_t* CKV; float* SSQ; const float* kn; bf16_t* IK; float* IW; const float* SS; PG8_LAS float* lred;
    __device__ __forceinline__ void operator()(const f32x4 (&acc_)[2][2][4][2], const Unit& u, int wr, int wc, int fr, int fq) const {
        epi_lane(fr, fq);
        const int row0 = u.pm * BM + wr * 64 + fr, cw = wc * 32 + 8 * fq;
        float rf[2][4];
#pragma unroll
        for (int ai = 0; ai < 2; ++ai)
#pragma unroll
            for (int m = 0; m < 4; ++m) { const f32x4* sp = (const f32x4*)(SS + (size_t)(row0 + ai * HALF + m * 16) * 8); const f32x4 s0 = sp[0], s1 = sp[1];
                rf[ai][m] = __builtin_amdgcn_rsqf(((((s0[0] + s0[1]) + (s0[2] + s0[3])) + ((s1[0] + s1[1]) + (s1[2] + s1[3])))) * (1.0f / 2048.0f) + 1e-6f); }
        asm volatile("s_waitcnt vmcnt(0)" ::: "memory"); __builtin_amdgcn_sched_barrier(0);
#define AV(ai_, bj_, m_, n_) (acc_[ai_][bj_][m_][n_] * rf[ai_][m_])
        if (u.pn < 3) {
#pragma unroll
            for (int ai = 0; ai < 2; ++ai)
#pragma unroll
                for (int m = 0; m < 4; ++m) { float ss = 0.f;
#pragma unroll
                    for (int bj = 0; bj < 2; ++bj)
#pragma unroll
                        for (int n = 0; n < 2; ++n) { const f32x4 v = AV(ai, bj, m, n); ss += (v[0] * v[0] + v[1] * v[1]) + (v[2] * v[2] + v[3] * v[3]); }
                    ss += __shfl_xor(ss, 16); ss += __shfl_xor(ss, 32); if (fq == 0) lred[(ai * HALF + wr * 64 + m * 16 + fr) * 4 + wc] = ss; }
            asm volatile("s_waitcnt lgkmcnt(0)" ::: "memory"); __builtin_amdgcn_s_barrier(); asm volatile("" ::: "memory");
            if (u.pn < 2) {
#pragma unroll
                for (int ai = 0; ai < 2; ++ai)
#pragma unroll
                    for (int m = 0; m < 4; ++m) { bf16_t* rowp = CQ + (size_t)(row0 + ai * HALF + m * 16) * 512 + u.pn * BM + cw;
#pragma unroll
                        for (int bj = 0; bj < 2; ++bj) *(u32x4*)(rowp + bj * HALF) = pack8_bf16(AV(ai, bj, m, 0), AV(ai, bj, m, 1)); }
                const int t = (wr * 4 + wc) * 64 + fq * 16 + fr;
                if (t < 256) { const f32x4 p = ((const PG8_LAS f32x4*)lred)[t]; SSQ[(size_t)(u.pm * BM + t) * 2 + u.pn] = (p[0] + p[1]) + (p[2] + p[3]); }
            } else {
                f32x4 kg[2][2];
#pragma unroll
                for (int bj = 0; bj < 2; ++bj) { kg[bj][0] = *(const f32x4*)(kn + bj * HALF + cw); kg[bj][1] = *(const f32x4*)(kn + bj * HALF + cw + 4); }
#pragma unroll
                for (int ai = 0; ai < 2; ++ai)
#pragma unroll
                    for (int m = 0; m < 4; ++m) { const f32x4 p = ((const PG8_LAS f32x4*)lred)[ai * HALF + wr * 64 + m * 16 + fr];
                        const float rk = __builtin_amdgcn_rsqf(((p[0] + p[1]) + (p[2] + p[3])) * (1.0f / 256.0f) + 1e-6f);
                        bf16_t* rowp = CKV + (size_t)(row0 + ai * HALF + m * 16) * 256 + cw;
#pragma unroll
                        for (int bj = 0; bj < 2; ++bj) *(u32x4*)(rowp + bj * HALF) = pack8_bf16(AV(ai, bj, m, 0) * kg[bj][0] * rk, AV(ai, bj, m, 1) * kg[bj][1] * rk); }
            }
        } else {
            if (wc < 2) {
#pragma unroll
                for (int ai = 0; ai < 2; ++ai)
#pragma unroll
                    for (int m = 0; m < 4; ++m) { const size_t r = (size_t)(row0 + ai * HALF + m * 16);
                        *(u32x4*)(IK + ((((r >> 5) * 4 + (2 * wc + (fq >> 1))) * 64 + (fq & 1) * 32 + (r & 31)) << 3)) = pack8_bf16(AV(ai, 0, m, 0), AV(ai, 0, m, 1)); }
            } else if (wc == 2 && fq < 2) {
#pragma unroll
                for (int ai = 0; ai < 2; ++ai)
#pragma unroll
                    for (int m = 0; m < 4; ++m) { float* rowp = IW + (size_t)(row0 + ai * HALF + m * 16) * 16 + 8 * fq;
                        *(f32x4*)rowp = AV(ai, 0, m, 0) * 0.03125f; *(f32x4*)(rowp + 4) = AV(ai, 0, m, 1) * 0.03125f; }
            }
        }
#undef AV
    }
};
struct EpiQ {
    static constexpr bool PERM = true, AFTER_DRAIN = false;
    bf16_t* O; int ldc; const float* SSQ;
    __device__ __forceinline__ void operator()(const f32x4 (&acc)[2][2][4][2], const Unit& u, int wr, int wc, int fr, int fq) const {
        epi_lane(fr, fq);
        const int row0 = u.pm * BM + wr * 64 + fr, col0 = u.pn * BM + wc * 32 + 8 * fq;
        float rf[2][4];
#pragma unroll
        for (int ai = 0; ai < 2; ++ai)
#pragma unroll
            for (int m = 0; m < 4; ++m) { const size_t row = (size_t)(row0 + ai * HALF + m * 16); typedef float f32x2_ __attribute__((ext_vector_type(2))); const f32x2_ s = *(const f32x2_*)(SSQ + row * 2);
                rf[ai][m] = __builtin_amdgcn_rsqf((s[0] + s[1]) * (1.0f / 512.0f) + 1e-6f); }
        asm volatile("s_waitcnt vmcnt(0)" ::: "memory"); __builtin_amdgcn_sched_barrier(0);
#pragma unroll
        for (int ai = 0; ai < 2; ++ai)
#pragma unroll
            for (int m = 0; m < 4; ++m) { bf16_t* rowp = O + (size_t)(row0 + ai * HALF + m * 16) * ldc + col0;
#pragma unroll
                for (int bj = 0; bj < 2; ++bj) *(u32x4*)(rowp + bj * HALF) = pack8_bf16(acc[ai][bj][m][0] * rf[ai][m], acc[ai][bj][m][1] * rf[ai][m]); }
    }
};
struct EpiAGate {
    static constexpr bool PERM = true, AFTER_DRAIN = false;
    bf16_t* GATE; const float* SS; const float* CS;
    __device__ __forceinline__ void operator()(const f32x4 (&acc_)[2][2][4][2], const Unit& u, int wr, int wc, int fr, int fq) const {
        epi_lane(fr, fq);
        const int row0 = u.pm * BM + wr * 64 + fr, cw = wc * 32 + 8 * fq;
        typedef unsigned u32x2 __attribute__((ext_vector_type(2)));
        float rf[2][4];
#pragma unroll
        for (int ai = 0; ai < 2; ++ai)
#pragma unroll
            for (int m = 0; m < 4; ++m) { const f32x4* sp = (const f32x4*)(SS + (size_t)(row0 + ai * HALF + m * 16) * 8); const f32x4 s0 = sp[0], s1 = sp[1];
                rf[ai][m] = __builtin_amdgcn_rsqf(((((s0[0] + s0[1]) + (s0[2] + s0[3])) + ((s1[0] + s1[1]) + (s1[2] + s1[3])))) * (1.0f / 2048.0f) + 1e-6f); }
        f32x4 cs[2][2];
#pragma unroll
        for (int bj = 0; bj < 2; ++bj) { cs[bj][0] = *(const f32x4*)(CS + u.pn * BM + bj * HALF + cw); cs[bj][1] = *(const f32x4*)(CS + u.pn * BM + bj * HALF + cw + 4); }
        asm volatile("s_waitcnt vmcnt(0)" ::: "memory"); __builtin_amdgcn_sched_barrier(0);
#pragma unroll
        for (int ai = 0; ai < 2; ++ai)
#pragma unroll
            for (int m = 0; m < 4; ++m) { const float r = rf[ai][m];
                unsigned char* rowp = (unsigned char*)GATE + (size_t)(row0 + ai * HALF + m * 16) * 2048 + u.pn * BM + cw;
#pragma unroll
                for (int bj = 0; bj < 2; ++bj) { const f32x4 v0 = __builtin_convertvector(__builtin_bit_cast(v4i32, acc_[ai][bj][m][0]), f32x4) * (cs[bj][0] * r), v1 = __builtin_convertvector(__builtin_bit_cast(v4i32, acc_[ai][bj][m][1]), f32x4) * (cs[bj][1] * r);
                    u32x2 w; w.x = q8x4(silu4(v0)); w.y = q8x4(silu4(v1)); *(u32x2*)(rowp + bj * HALF) = w; } }
    }
};
struct EpiBIn {
    static constexpr bool PERM = true, AFTER_DRAIN = false;
    bf16_t* QKV; size_t qkv_stride; bf16_t* GATE; float* LF; const float* fbias; const float* SS; const float* CS;
    __device__ __forceinline__ void operator()(const f32x4 (&acc_)[2][2][4][2], const Unit& u, int wr, int wc, int fr, int fq) const {
        epi_lane(fr, fq);
        const int row0 = u.pm * BM + wr * 64 + fr, cw = wc * 32 + 8 * fq;
        float rf[2][4];
#pragma unroll
        for (int ai = 0; ai < 2; ++ai)
#pragma unroll
            for (int m = 0; m < 4; ++m) { const f32x4* sp = (const f32x4*)(SS + (size_t)(row0 + ai * HALF + m * 16) * 8); const f32x4 s0 = sp[0], s1 = sp[1];
                rf[ai][m] = __builtin_amdgcn_rsqf(((((s0[0] + s0[1]) + (s0[2] + s0[3])) + ((s1[0] + s1[1]) + (s1[2] + s1[3])))) * (1.0f / 2048.0f) + 1e-6f); }
        f32x4 cs[2][2], fb0 = (f32x4){0.f, 0.f, 0.f, 0.f}, fb1 = fb0;
#pragma unroll
        for (int bj = 0; bj < 2; ++bj)
#pragma unroll
            for (int n = 0; n < 2; ++n) cs[bj][n] = *(const f32x4*)(CS + u.pn * BM + bj * HALF + cw + 4 * n);
        if (u.pn == 32 && wc == 0 && fq < 2) { fb0 = *(const f32x4*)(fbias + 8 * fq); fb1 = *(const f32x4*)(fbias + 8 * fq + 4); }
        asm volatile("s_waitcnt vmcnt(0)" ::: "memory"); __builtin_amdgcn_sched_barrier(0);
        f32x4 acc[2][2][4][2];
#pragma unroll
        for (int ai = 0; ai < 2; ++ai)
#pragma unroll
            for (int m = 0; m < 4; ++m)
#pragma unroll
                for (int bj = 0; bj < 2; ++bj)
#pragma unroll
                    for (int n = 0; n < 2; ++n) acc[ai][bj][m][n] = __builtin_convertvector(__builtin_bit_cast(v4i32, acc_[ai][bj][m][n]), f32x4) * (cs[bj][n] * rf[ai][m]);
        if (u.pn < 16) {
            unsigned char* base = (unsigned char*)(QKV + (size_t)(u.pn >> 3) * qkv_stride) + (u.pn & 7) * BM + cw;
            typedef unsigned u32x2 __attribute__((ext_vector_type(2)));
#pragma unroll
            for (int ai = 0; ai < 2; ++ai)
#pragma unroll
                for (int m = 0; m < 4; ++m) { unsigned char* rowp = base + (size_t)(row0 + ai * HALF + m * 16) * 2048;
                    u32x2_t w0, w1; w0.x = q8x4(acc[ai][0][m][0]); w0.y = q8x4(acc[ai][0][m][1]); w1.x = q8x4(acc[ai][1][m][0]); w1.y = q8x4(acc[ai][1][m][1]); st8x2_wide(rowp, fq, w0, w1); }
        } else if (u.pn < 24) {
            bf16_t* base = QKV + (size_t)(u.pn >> 3) * qkv_stride + (u.pn & 7) * BM + cw;
#pragma unroll
            for (int ai = 0; ai < 2; ++ai)
#pragma unroll
                for (int m = 0; m < 4; ++m) { bf16_t* rowp = base + (size_t)(row0 + ai * HALF + m * 16) * 2048;
#pragma unroll
                    for (int bj = 0; bj < 2; ++bj) *(u32x4*)(rowp + bj * HALF) = pack8_bf16(acc[ai][bj][m][0], acc[ai][bj][m][1]); }
        } else if (u.pn < 32) {
#pragma unroll
            for (int ai = 0; ai < 2; ++ai)
#pragma unroll
                for (int m = 0; m < 4; ++m) { unsigned char* rowp = (unsigned char*)GATE + (size_t)(row0 + ai * HALF + m * 16) * 2048 + (u.pn - 24) * BM + cw; typedef unsigned u32x2 __attribute__((ext_vector_type(2)));
                    u32x2_t w0, w1; w0.x = q8x4(silu4(acc[ai][0][m][0])); w0.y = q8x4(silu4(acc[ai][0][m][1])); w1.x = q8x4(silu4(acc[ai][1][m][0])); w1.y = q8x4(silu4(acc[ai][1][m][1])); st8x2_wide(rowp, fq, w0, w1); }
        } else if (wc == 0 && fq < 2) {
            const f32x4 b0 = fb0, b1 = fb1;
#pragma unroll
            for (int ai = 0; ai < 2; ++ai)
#pragma unroll
                for (int m = 0; m < 4; ++m) { float* rowp = LF + (size_t)(row0 + ai * HALF + m * 16) * 16 + 8 * fq;
                    f32x4 x0 = acc[ai][0][m][0] + b0, x1 = acc[ai][0][m][1] + b1, y0, y1;
#pragma unroll
                    for (int i = 0; i < 4; ++i) { y0[i] = fminf(x0[i], 0.f) - __logf(1.0f + __expf(-fabsf(x0[i]))); y1[i] = fminf(x1[i], 0.f) - __logf(1.0f + __expf(-fabsf(x1[i]))); }
                    *(f32x4*)rowp = y0; *(f32x4*)(rowp + 4) = y1; }
        }
    }
};
struct EpiUV {
    static constexpr bool PERM = true, AFTER_DRAIN = false;
    bf16_t* O; const float* RS; const float* CS;
    __device__ __forceinline__ void operator()(const f32x4 (&acc)[2][2][4][2], const Unit& u, int wr, int wc, int fr, int fq) const {
        epi_lane(fr, fq);
        const int row0 = u.pm * BM + wr * 64 + fr, col0 = u.pn * BM + wc * 32 + 8 * fq;
#pragma unroll
        for (int ai = 0; ai < 2; ++ai) {
            f32x4 cs[2][2]; float rs[4];
#pragma unroll
            for (int bj = 0; bj < 2; ++bj) { cs[bj][0] = *(const f32x4*)(CS + col0 + bj * HALF); cs[bj][1] = *(const f32x4*)(CS + col0 + bj * HALF + 4); }
#pragma unroll
            for (int m = 0; m < 4; ++m) rs[m] = RS[row0 + ai * HALF + m * 16];
            asm volatile("s_waitcnt vmcnt(0)" ::: "memory"); __builtin_amdgcn_sched_barrier(0);
#pragma unroll
            for (int m = 0; m < 4; ++m) { bf16_t* rowp = O + (size_t)(row0 + ai * HALF + m * 16) * 2048 + col0;
#pragma unroll
                for (int bj = 0; bj < 2; ++bj) *(u32x4*)(rowp + bj * HALF) = pack8_bf16(__builtin_convertvector(__builtin_bit_cast(v4i32, acc[ai][bj][m][0]), f32x4) * (cs[bj][0] * rs[m]), __builtin_convertvector(__builtin_bit_cast(v4i32, acc[ai][bj][m][1]), f32x4) * (cs[bj][1] * rs[m])); }
            __builtin_amdgcn_sched_barrier(0);
        }
    }
};
template <bool BASE32  > struct EpiRes {
    static constexpr bool PERM = true, AFTER_DRAIN = false;
    const float* B32; bf16_t* OB; bf16_t* R; unsigned char* Q8; float* SSP; PG8_LAS float* lred; const float* RS; const float* CS;
    struct Raw { u32x4 w[2][2][BASE32 ? 2 : 1]; };
    __device__ __forceinline__ void load_q(Raw& q, int gq, int row0, int col0) const {
        const int ai = gq >> 1, m0 = 2 * (gq & 1);
#pragma unroll
        for (int mm = 0; mm < 2; ++mm)
#pragma unroll
            for (int bj = 0; bj < 2; ++bj) { const size_t o = (size_t)(row0 + ai * HALF + (m0 + mm) * 16) * 2048 + col0 + bj * HALF;
                if constexpr (BASE32) { q.w[mm][bj][0] = *(const u32x4*)(B32 + o); q.w[mm][bj][1] = *(const u32x4*)(B32 + o + 4); } else q.w[mm][bj][0] = *(const u32x4*)(R + o); }
    }
    __device__ __forceinline__ void operator()(const f32x4 (&acc)[2][2][4][2], const Unit& u, int wr, int wc, int fr, int fq) const {
        epi_lane(fr, fq);
        const int row0 = u.pm * BM + wr * 64 + fr, col0 = u.pn * BM + wc * 32 + 8 * fq;
        typedef unsigned u32x2 __attribute__((ext_vector_type(2)));
        f32x4 cs[2][2]; float rs[2][4];
#pragma unroll
        for (int bj = 0; bj < 2; ++bj) { cs[bj][0] = *(const f32x4*)(CS + col0 + bj * HALF); cs[bj][1] = *(const f32x4*)(CS + col0 + bj * HALF + 4); }
#pragma unroll
        for (int ai = 0; ai < 2; ++ai)
#pragma unroll
            for (int m = 0; m < 4; ++m) rs[ai][m] = RS[row0 + ai * HALF + m * 16];
        Raw qa, qb;
        load_q(qa, 0, row0, col0);
        __builtin_amdgcn_sched_barrier(0);
#define RES_QUARTER(cur_, gq_) do { const int ai = (gq_) >> 1, m0 = 2 * ((gq_) & 1); \
            _Pragma("unroll") for (int mm = 0; mm < 2; ++mm) { const int m = m0 + mm; const size_t ro = (size_t)(row0 + ai * HALF + m * 16) * 2048 + col0; float ss = 0.f; const float r_ = rs[ai][m]; \
                _Pragma("unroll") for (int bj = 0; bj < 2; ++bj) { const size_t o = ro + bj * HALF; f32x4 b0, b1; \
                    if constexpr (BASE32) { b0 = __builtin_bit_cast(f32x4, cur_.w[mm][bj][0]); b1 = __builtin_bit_cast(f32x4, cur_.w[mm][bj][BASE32 ? 1 : 0]); } \
                    else { const u32x4 g = cur_.w[mm][bj][0]; b0 = (f32x4){bf_lo(g.x), bf_hi(g.x), bf_lo(g.y), bf_hi(g.y)}; b1 = (f32x4){bf_lo(g.z), bf_hi(g.z), bf_lo(g.w), bf_hi(g.w)}; } \
                    const f32x4 v0 = b0 + __builtin_convertvector(__builtin_bit_cast(v4i32, acc[ai][bj][m][0]), f32x4) * (cs[bj][0] * r_), v1 = b1 + __builtin_convertvector(__builtin_bit_cast(v4i32, acc[ai][bj][m][1]), f32x4) * (cs[bj][1] * r_); \
                    *(u32x4*)((OB ? OB : R) + o) = pack8_bf16(v0, v1); \
                    if (Q8) { u32x2 w; w.x = q8x4(v0); w.y = q8x4(v1); *(u32x2*)(Q8 + o) = w; } \
                    ss += ((v0[0] * v0[0] + v0[1] * v0[1]) + (v0[2] * v0[2] + v0[3] * v0[3])) + ((v1[0] * v1[0] + v1[1] * v1[1]) + (v1[2] * v1[2] + v1[3] * v1[3])); } \
                if (SSP) { ss += __shfl_xor(ss, 16); ss += __shfl_xor(ss, 32); if (fq == 0) lred[(ai * HALF + wr * 64 + m * 16 + fr) * 4 + wc] = ss; } } \
            __builtin_amdgcn_sched_barrier(0); } while (0)
        if constexpr (BASE32) {
            RES_QUARTER(qa, 0); load_q(qa, 1, row0, col0); __builtin_amdgcn_sched_barrier(0); RES_QUARTER(qa, 1); load_q(qa, 2, row0, col0); __builtin_amdgcn_sched_barrier(0); RES_QUARTER(qa, 2);
            load_q(qa, 3, row0, col0); __builtin_amdgcn_sched_barrier(0); RES_QUARTER(qa, 3); (void)qb;
        } else {
            load_q(qb, 1, row0, col0); __builtin_amdgcn_sched_barrier(0); RES_QUARTER(qa, 0);
            load_q(qa, 2, row0, col0); __builtin_amdgcn_sched_barrier(0); RES_QUARTER(qb, 1);
            load_q(qb, 3, row0, col0); __builtin_amdgcn_sched_barrier(0); RES_QUARTER(qa, 2);
            RES_QUARTER(qb, 3);
        }
#undef RES_QUARTER
        if (SSP) {
            asm volatile("s_waitcnt lgkmcnt(0)" ::: "memory"); __builtin_amdgcn_s_barrier(); asm volatile("" ::: "memory");
            const int t = (wr * 4 + wc) * 64 + fq * 16 + fr;
            if (t < 256) { const f32x4 p = ((const PG8_LAS f32x4*)lred)[t]; SSP[(size_t)(u.pm * BM + t) * 8 + u.pn] = (p[0] + p[1]) + (p[2] + p[3]); }
        }
    }
};

template <class Epi, class Sched, bool ALIGN_EPI = false, bool SP2 = false, int OPK = 0  >
__device__ __forceinline__ void gemm_phase(PG8_LAS unsigned char* lds, const Gemm g, const Sched& S, const Epi& E, const int tidv) {
    const int tid = tidv, wid = __builtin_amdgcn_readfirstlane(tid >> 6), lane = tid & 63, wr = wid >> 2, wc = wid & 3, fr = lane & 15, fq = lane >> 4;
    const int K = g.K, nt = K / BK, lda = g.lda;
    unsigned voffA[2], voffB[2];
#pragma unroll
    for (int i = 0; i < 2; ++i) { int R, C; stage_rc(tid * 16 + i * 8192, R, C); const int Rb = Epi::PERM ? ((R & ~31) + perm32(R & 31)) : R;
        voffA[i] = (unsigned)(R * lda + C) * 2u; voffB[i] = (unsigned)(Rb * K + C) * 2u; }
    const size_t kstep = (size_t)(BK * 2);
    const size_t hstep = (size_t)HALF * K * 2;
    const size_t hstepA = (size_t)HALF * lda * 2, tstepA = 2 * hstepA, apn = (size_t)g.a_pn_off * 2;
    const size_t tstep = 2 * hstep;
    const unsigned ldsw = (unsigned)wid * 1024u;
    const int aoff = lds_byte(wr * 64 + fr, fq * 8), boff = lds_byte(wc * 32 + fr, fq * 8);
#define PG8_SA(b, h) (((b) * 2 + (h)) * HTB)
#define PG8_SB(b, h) ((4 + (b) * 2 + (h)) * HTB)
#define PG8_STAGE(bufoff, gbase, voff) do { _Pragma("unroll") for (int _i = 0; _i < 2; ++_i) \
        __builtin_amdgcn_global_load_lds((const unsigned*)((const char*)(gbase) + (voff)[_i]), (PG8_LAS unsigned*)(lds + (bufoff) + ldsw + _i * 8192), 16, 0, 0); } while (0)
#define PG8_LDA(dst, b, h) do { _Pragma("unroll") for (int m = 0; m < 4; ++m) FragT<OPK>::load(dst[m], lds + PG8_SA(b, h) + aoff + m * 2048); } while (0)
#define PG8_LDB(dst, b, h) do { _Pragma("unroll") for (int n = 0; n < 2; ++n) FragT<OPK>::load(dst[n], lds + PG8_SB(b, h) + boff + n * 2048); } while (0)
#define PG8_MMA(ai, bj, At, Bt) do { __builtin_amdgcn_s_setprio(1); _Pragma("unroll") for (int m = 0; m < 4; ++m) _Pragma("unroll") for (int n = 0; n < 2; ++n) { \
        acc[ai][bj][m][n] = FragT<OPK>::mma(Bt[n], At[m], acc[ai][bj][m][n]); } __builtin_amdgcn_s_setprio(0); } while (0)
#define PG8_WAIT_V(n) asm volatile("s_waitcnt vmcnt(" #n ")" ::: "memory")
#define PG8_WAIT_L(n) asm volatile("s_waitcnt lgkmcnt(" #n ")" ::: "memory")
#define PG8_BAR __builtin_amdgcn_s_barrier()
#define PG8_SCHED __builtin_amdgcn_sched_barrier(0)
    Unit cur, nxt; int ui = 0;
    if (!S.next(0, cur)) return;
    f32x4 acc[2][2][4][2];
#pragma unroll
    for (int a = 0; a < 2; ++a)
#pragma unroll
        for (int b = 0; b < 2; ++b)
#pragma unroll
            for (int m = 0; m < 4; ++m)
#pragma unroll
                for (int n = 0; n < 2; ++n) acc[a][b][m][n] = (f32x4){0.f, 0.f, 0.f, 0.f};
    typename FragT<OPK>::type At[4], B0[2], B1[2];
    const char* cA = (const char*)g.A + (size_t)cur.pm * tstepA + (size_t)cur.pn * apn; const char* cB = (const char*)g.Bt + (size_t)cur.pn * tstep;
    S.a_ready(cur);
    if constexpr (SP2) {
        PG8_STAGE(PG8_SB(0, 0), cB, voffB); PG8_STAGE(PG8_SB(0, 1), cB + hstep, voffB); PG8_STAGE(PG8_SA(0, 0), cA, voffA); PG8_STAGE(PG8_SA(0, 1), cA + hstepA, voffA);
        if (wr == 1) PG8_BAR;
        PG8_WAIT_V(2); PG8_BAR;
        PG8_STAGE(PG8_SB(1, 0), cB + kstep, voffB); PG8_STAGE(PG8_SA(1, 0), cA + kstep, voffA); PG8_STAGE(PG8_SB(1, 1), cB + hstep + kstep, voffB);
        PG8_WAIT_V(6); PG8_BAR;
    } else {
        PG8_STAGE(PG8_SB(0, 0), cB, voffB); PG8_STAGE(PG8_SA(0, 0), cA, voffA); PG8_STAGE(PG8_SB(0, 1), cB + hstep, voffB); PG8_STAGE(PG8_SA(0, 1), cA + hstepA, voffA);
        if (wr == 1) PG8_BAR;
        PG8_WAIT_V(4); PG8_BAR;
        PG8_STAGE(PG8_SB(1, 0), cB + kstep, voffB); PG8_STAGE(PG8_SA(1, 0), cA + kstep, voffA); PG8_STAGE(PG8_SB(1, 1), cB + hstep + kstep, voffB);
        PG8_WAIT_V(6); PG8_BAR;
    }
    for (;;) {
        const bool has_next = S.next(ui + 1, nxt);
        const char* nA = has_next ? (const char*)g.A + (size_t)nxt.pm * tstepA + (size_t)nxt.pn * apn : cA; const char* nB = has_next ? (const char*)g.Bt + (size_t)nxt.pn * tstep : cB;
        for (int t = 0; t < nt; t += 2) {
            const bool last = (t == nt - 2);
            const char* a1 = cA + (size_t)(t + 1) * kstep;
            const char* a2 = last ? nA : cA + (size_t)(t + 2) * kstep; const char* b2 = last ? nB : cB + (size_t)(t + 2) * kstep;
            const char* a3 = a2 + kstep; const char* b3 = b2 + kstep;
            if (last && has_next) S.a_ready(nxt);
            if constexpr (SP2) {
            PG8_LDB(B0, 0, 0); PG8_LDB(B1, 0, 1); PG8_SCHED; PG8_LDA(At, 0, 0); PG8_STAGE(PG8_SA(1, 1), a1 + hstepA, voffA);
            PG8_WAIT_V(8); PG8_WAIT_L(0); PG8_BAR; PG8_MMA(0, 0, At, B0); PG8_MMA(0, 1, At, B1); PG8_BAR; PG8_SCHED;
            PG8_LDA(At, 0, 1); PG8_STAGE(PG8_SB(0, 0), b2, voffB); PG8_STAGE(PG8_SB(0, 1), b2 + hstep, voffB); PG8_STAGE(PG8_SA(0, 0), a2, voffA);
            PG8_WAIT_V(8); PG8_WAIT_L(0); PG8_BAR; PG8_MMA(1, 0, At, B0); PG8_MMA(1, 1, At, B1); PG8_BAR; PG8_SCHED;
            PG8_LDB(B0, 1, 0); PG8_LDB(B1, 1, 1); PG8_SCHED; PG8_LDA(At, 1, 0); PG8_STAGE(PG8_SA(0, 1), a2 + hstepA, voffA);
            PG8_WAIT_V(8); PG8_WAIT_L(0); PG8_BAR; PG8_MMA(0, 0, At, B0); PG8_MMA(0, 1, At, B1); PG8_BAR; PG8_SCHED;
            PG8_LDA(At, 1, 1); PG8_STAGE(PG8_SB(1, 0), b3, voffB); PG8_STAGE(PG8_SB(1, 1), b3 + hstep, voffB); PG8_STAGE(PG8_SA(1, 0), a3, voffA);
            PG8_WAIT_V(8); PG8_WAIT_L(0); PG8_BAR; PG8_MMA(1, 0, At, B0); PG8_MMA(1, 1, At, B1); PG8_BAR; PG8_SCHED;
            } else {
            PG8_LDB(B0, 0, 0); PG8_SCHED; PG8_LDA(At, 0, 0); PG8_STAGE(PG8_SA(1, 1), a1 + hstepA, voffA);
            PG8_WAIT_L(8); PG8_BAR; PG8_WAIT_L(0); PG8_MMA(0, 0, At, B0); PG8_BAR; PG8_SCHED;
            PG8_LDB(B1, 0, 1); PG8_STAGE(PG8_SB(0, 0), b2, voffB);
            PG8_BAR; PG8_WAIT_L(0); PG8_MMA(0, 1, At, B1); PG8_BAR;
            PG8_LDA(At, 0, 1); PG8_STAGE(PG8_SA(0, 0), a2, voffA);
            PG8_BAR; PG8_WAIT_L(0); PG8_MMA(1, 0, At, B0); PG8_BAR; PG8_SCHED;
            PG8_STAGE(PG8_SB(0, 1), b2 + hstep, voffB);
            PG8_WAIT_V(6); PG8_BAR; PG8_MMA(1, 1, At, B1); PG8_BAR;
            PG8_LDB(B0, 1, 0); PG8_SCHED; PG8_LDA(At, 1, 0); PG8_STAGE(PG8_SA(0, 1), a2 + hstepA, voffA);
            PG8_WAIT_L(8); PG8_BAR; PG8_WAIT_L(0); PG8_MMA(0, 0, At, B0); PG8_BAR; PG8_SCHED;
            PG8_LDB(B1, 1, 1); PG8_STAGE(PG8_SB(1, 0), b3, voffB);
            PG8_BAR; PG8_WAIT_L(0); PG8_MMA(0, 1, At, B1); PG8_BAR;
            PG8_LDA(At, 1, 1); PG8_STAGE(PG8_SA(1, 0), a3, voffA);
            PG8_BAR; PG8_WAIT_L(0); PG8_MMA(1, 0, At, B0); PG8_BAR; PG8_SCHED;
            PG8_STAGE(PG8_SB(1, 1), b3 + hstep, voffB);
            PG8_WAIT_V(6); PG8_BAR; PG8_MMA(1, 1, At, B1); PG8_BAR;
            }
        }
        if constexpr (ALIGN_EPI) { if (wr == 0) PG8_BAR; }
        if constexpr (!Epi::AFTER_DRAIN) { E(acc, cur, wr, wc, fr, fq); S.done(cur); }
        if (!has_next) break;
#pragma unroll
        for (int a = 0; a < 2; ++a)
#pragma unroll
            for (int b = 0; b < 2; ++b)
#pragma unroll
                for (int m = 0; m < 4; ++m)
#pragma unroll
                    for (int n = 0; n < 2; ++n) acc[a][b][m][n] = (f32x4){0.f, 0.f, 0.f, 0.f};
        cur = nxt; cA = nA; cB = nB; ++ui;
        if constexpr (ALIGN_EPI) { if (wr == 1) PG8_BAR; }
    }
    PG8_WAIT_V(0);
    if constexpr (!ALIGN_EPI) { if (wr == 0) PG8_BAR; }
    PG8_BAR;
    if constexpr (Epi::AFTER_DRAIN) { E.fused(acc, cur, wr, wc, fr, fq, lds, wid, lane); S.done(cur); }
#undef PG8_SA
#undef PG8_SB
#undef PG8_STAGE
#undef PG8_LDA
#undef PG8_LDB
#undef PG8_MMA
#undef PG8_WAIT_V
#undef PG8_WAIT_L
#undef PG8_BAR
#undef PG8_SCHED
}
}

namespace fox {
enum { ORDER_NATURAL = 0, ORDER_REVERSED = 1, ORDER_PAIRED = 2, ORDER_XCD = 4 };
constexpr int D = 128, LDX = 2048;
constexpr float THR = 8.f;
constexpr bool WSKIP = false;
constexpr float SCALE = 0.08838834764831845f / 256.0f;
constexpr int NW = 8, QBLK = 32, KVBLK = 64, QB = NW * QBLK;
constexpr int SHM_V = KVBLK * D * 2, SHM_K = KVBLK * D * 2;
constexpr int LDS_BYTES = 2 * SHM_V + 2 * SHM_K + NW * 64 * 4;
constexpr int CB_OFF = LDS_BYTES;
constexpr int LDS_TOTAL = CB_OFF + 4096 * 4;

using bf16 = __hip_bfloat16;
typedef short bf16x8 __attribute__((ext_vector_type(8)));
typedef short s16x4 __attribute__((ext_vector_type(4)));
typedef float f32x16 __attribute__((ext_vector_type(16)));
typedef float f32x4 __attribute__((ext_vector_type(4)));
typedef unsigned u32x4 __attribute__((ext_vector_type(4)));
template <class A, class Bt> struct same_t { static constexpr bool v = false; };
template <class A> struct same_t<A, A> { static constexpr bool v = true; };

#define KSWZ(row, colB) ((row) * 256 + ((colB) ^ (((row) & 7) << 4)))
#define SBAR() __builtin_amdgcn_sched_barrier(0)
__device__ __forceinline__ int v_st(int k, int c) { const int kk = (k & ~0xC) | ((k & 4) << 1) | ((k & 8) >> 1); return ((kk >> 3) * 4 + (c >> 5)) * 512 + ((kk & 7) * 32 + (c & 31)) * 2; }
__device__ __forceinline__ int v_rd_base(int lane) { return ((lane & 3) << 3) | (((lane >> 2) & 3) << 6) | (((lane >> 4) & 1) << 5) | (((lane >> 5) & 1) << 8); }
constexpr int v_rd_off(int d0, int ks, int half) { return d0 * 512 + ks * 4096 + half * 2048; }
__device__ __forceinline__ int crow(int r, int hi) { return (r & 3) + 8 * (r >> 2) + 4 * hi; }
__device__ __forceinline__ unsigned cvtpk(float lo, float hi) {
    unsigned r; asm volatile("v_cvt_pk_bf16_f32 %0, %1, %2" : "=v"(r) : "v"(lo), "v"(hi)); return r;
}
__device__ __forceinline__ bf16x8 pack8(f32x4 a, f32x4 b) {
    u32x4 w = {cvtpk(a[0], a[1]), cvtpk(a[2], a[3]), cvtpk(b[0], b[1]), cvtpk(b[2], b[3])};
    return *reinterpret_cast<bf16x8*>(&w);
}
template <class T> __device__ __forceinline__ bf16x8 load8(const T* p) {
    if constexpr (same_t<T, float>::v) { return pack8(*(const f32x4*)p, *(const f32x4*)(p + 4)); }
    else { return *reinterpret_cast<const bf16x8*>(p); }
}
__device__ __forceinline__ void mask_tile(f32x16& p0, f32x16& p1, int dq, unsigned W) {
    const float NEG = -__builtin_inff();
#pragma unroll
    for (int r = 0; r < 16; ++r) {
        const int c = (r & 3) + 8 * (r >> 2);
        if ((unsigned)(dq - c) >= W) p0[r] = NEG;
        if ((unsigned)(dq - c - 32) >= W) p1[r] = NEG;
    }
}
__device__ __forceinline__ void partialSM(f32x16& p0, f32x16& p1, float& m_reg, float& mn, float& alpha) {
    float pmax = p0[0]; for (int r = 1; r < 16; ++r) pmax = fmaxf(pmax, p0[r]); for (int r = 0; r < 16; ++r) pmax = fmaxf(pmax, p1[r]);
    { auto rr = __builtin_amdgcn_permlane32_swap(__float_as_uint(pmax), __float_as_uint(pmax), false, false);
      pmax = fmaxf(__uint_as_float(rr[0]), __uint_as_float(rr[1])); }
    constexpr float C2 = 1.4426950408889634f * SCALE;
    if (__builtin_expect(__all((pmax - m_reg) * SCALE <= THR), 1)) { mn = m_reg; alpha = 1.f; }
    else { mn = fmaxf(m_reg, pmax); alpha = __builtin_amdgcn_exp2f((m_reg - mn) * C2); m_reg = mn; }
    const float mnL = -mn * C2;
    for (int r = 0; r < 16; ++r) p0[r] = fmaf(p0[r], C2, mnL); for (int r = 0; r < 16; ++r) p1[r] = fmaf(p1[r], C2, mnL);
    for (int r = 0; r < 16; ++r) p0[r] = __builtin_amdgcn_exp2f(p0[r]);
}
__device__ __forceinline__ void finishSM(f32x16& p0, f32x16& p1, float alpha, float& l_reg, bf16x8& pa0, bf16x8& pa1, bf16x8& pa2, bf16x8& pa3) {
    for (int r = 0; r < 16; ++r) p1[r] = __builtin_amdgcn_exp2f(p1[r]);
    float ps = 0; for (int r = 0; r < 16; ++r) ps += p0[r]; for (int r = 0; r < 16; ++r) ps += p1[r];
    { auto rr = __builtin_amdgcn_permlane32_swap(__float_as_uint(ps), __float_as_uint(ps), false, false);
      ps = __uint_as_float(rr[0]) + __uint_as_float(rr[1]); }
    l_reg = l_reg * alpha + ps;
#define PK4(P, B_, OUT) do { unsigned a0 = cvtpk(P[B_+0], P[B_+1]), a1 = cvtpk(P[B_+2], P[B_+3]);                          \
        unsigned b0 = cvtpk(P[B_+4], P[B_+5]), b1 = cvtpk(P[B_+6], P[B_+7]);                                             \
        auto r0 = __builtin_amdgcn_permlane32_swap(a0, b0, false, false); auto r1 = __builtin_amdgcn_permlane32_swap(a1, b1, false, false); \
        u32x4 w = {r0[0], r1[0], r0[1], r1[1]}; OUT = *reinterpret_cast<bf16x8*>(&w); } while (0)
    PK4(p0, 0, pa0); PK4(p0, 8, pa1); PK4(p1, 0, pa2); PK4(p1, 8, pa3);
#undef PK4
}
template <int KB, bool SK>
__device__ __forceinline__ void qkt(f32x16& p0, f32x16& p1, const char* K_lds, int r32, int hi, const bf16x8* qr, bool act, const int* cbt) {
    typedef int v16i __attribute__((ext_vector_type(16))); typedef int v4i_ __attribute__((ext_vector_type(4)));
    v16i a0, a1;
    { int hi2 = hi; asm volatile("" : "+v"(hi2));
      const v4i_* c4 = (const v4i_*)cbt + hi2;
      const v4i_ x0 = c4[0], x1 = c4[2], x2 = c4[4], x3 = c4[6], y0 = c4[8], y1 = c4[10], y2 = c4[12], y3 = c4[14];
      a0 = (v16i){x0[0], x0[1], x0[2], x0[3], x1[0], x1[1], x1[2], x1[3], x2[0], x2[1], x2[2], x2[3], x3[0], x3[1], x3[2], x3[3]};
      a1 = (v16i){y0[0], y0[1], y0[2], y0[3], y1[0], y1[1], y1[2], y1[3], y2[0], y2[1], y2[2], y2[3], y3[0], y3[1], y3[2], y3[3]}; }
    const char* kb[4];
#pragma unroll
    for (int s = 0; s < 4; ++s) kb[s] = K_lds + KB * SHM_K + r32 * 128 + 16 * ((2 * s + hi) ^ ((r32 >> 1) & 7));
#pragma unroll
    for (int s = 0; s < 4; ++s) {
        const v4i_ b0 = *reinterpret_cast<const v4i_*>(kb[s]), b1 = *reinterpret_cast<const v4i_*>(kb[s] + 32 * 128), q = __builtin_bit_cast(v4i_, qr[s]);
        a0 = __builtin_amdgcn_mfma_i32_32x32x32_i8(b0, q, a0, 0, 0, 0);
        a1 = __builtin_amdgcn_mfma_i32_32x32x32_i8(b1, q, a1, 0, 0, 0); }
    p0 = __builtin_convertvector(a0, f32x16); p1 = __builtin_convertvector(a1, f32x16);
}
template <int VB, bool SK>
__device__ __forceinline__ void pv_tile(f32x16* o, int vb0, bf16x8 pa0, bf16x8 pa1, bf16x8 pa2, bf16x8 pa3, bool act) {
    if (SK && !act) return;
#define TRRD(dst, off) asm volatile("ds_read_b64_tr_b16 %0, %1 offset:%2" : "=&v"(dst) : "v"(vb0), "i"(off) : "memory")
#define PV_D0(d0) do { s16x4 l0, l1, l2, l3, h0, h1, h2, h3; constexpr int b_ = VB * SHM_V + v_rd_off(d0, 0, 0);     \
        TRRD(l0, b_); TRRD(h0, b_ + 2048); TRRD(l1, b_ + 4096); TRRD(h1, b_ + 6144); TRRD(l2, b_ + 8192); TRRD(h2, b_ + 10240); TRRD(l3, b_ + 12288); TRRD(h3, b_ + 14336); \
        asm volatile("s_waitcnt lgkmcnt(0)" ::: "memory"); SBAR();                 \
        o[d0] = __builtin_amdgcn_mfma_f32_32x32x16_bf16(pa0, (bf16x8){l0[0], l0[1], l0[2], l0[3], h0[0], h0[1], h0[2], h0[3]}, o[d0], 0, 0, 0);   \
        o[d0] = __builtin_amdgcn_mfma_f32_32x32x16_bf16(pa1, (bf16x8){l1[0], l1[1], l1[2], l1[3], h1[0], h1[1], h1[2], h1[3]}, o[d0], 0, 0, 0);   \
        o[d0] = __builtin_amdgcn_mfma_f32_32x32x16_bf16(pa2, (bf16x8){l2[0], l2[1], l2[2], l2[3], h2[0], h2[1], h2[2], h2[3]}, o[d0], 0, 0, 0);   \
        o[d0] = __builtin_amdgcn_mfma_f32_32x32x16_bf16(pa3, (bf16x8){l3[0], l3[1], l3[2], l3[3], h3[0], h3[1], h3[2], h3[3]}, o[d0], 0, 0, 0); } while (0)
    PV_D0(0); PV_D0(1); PV_D0(2); PV_D0(3);
#undef PV_D0
#undef TRRD
}

template <class TIn, class TOut> struct BlockRef { const unsigned char* Q8; const unsigned char* K8; const TIn* Vp; TOut* Op; const unsigned char* Gp; int P0; int R0; int HH;
    __device__ __forceinline__ const TIn* V() const { return Vp; }
    __device__ __forceinline__ TOut* O() const { return Op; }
    __device__ __forceinline__ const unsigned char* G() const { return Gp; } };
template <class TIn> struct Seam {
    bf16x8 qr[8];
    bf16x8 st_v0, st_v1, st_k0, st_k1; f32x4 sf0, sf1, sf2, sf3;
    f32x4 tq[16];
};
__device__ __forceinline__ int swa_jlo(int P0, int W) { const int lowk = P0 - W + 1; return lowk > 0 ? lowk / KVBLK : 0; }
#define ROW(p, k0, rr) ((const TIn*)((const char*)((p) + (size_t)(k0) * LDX) + (unsigned)(((rr) * LDX + sc) * 2)))
#define VMW() asm volatile("s_waitcnt vmcnt(0)" ::: "memory")
#define VMWN(n) asm volatile("s_waitcnt vmcnt(%0)" :: "i"(n) : "memory")
#define SLOAD_H(Kp, Vp, k0) do { S.st_v0 = load8<TIn>(ROW(Vp, k0, sr)); S.st_v1 = load8<TIn>(ROW(Vp, k0, 32 + sr));              \
                         S.st_k0 = *(const bf16x8*)((Kp) + (size_t)(k0) * LDX + kg8); } while (0)
#define SWRITE_HK(bf) do { *(bf16x8*)(K_lds + (bf) * SHM_K + kws) = S.st_k0; } while (0)
#define SWRITE_HV(bf) do { *(bf16x8*)(V_lds + (bf) * SHM_V + vst0) = S.st_v0; *(bf16x8*)(V_lds + (bf) * SHM_V + vst1) = S.st_v1; } while (0)
#define SWRITE_H(bf) do { SWRITE_HV(bf); SWRITE_HK(bf); } while (0)
#define SLOAD_F(p, k0) do { S.sf0 = *(const f32x4*)ROW(p, k0, sr); S.sf1 = *(const f32x4*)(ROW(p, k0, sr) + 4);                \
                            S.sf2 = *(const f32x4*)ROW(p, k0, 32 + sr); S.sf3 = *(const f32x4*)(ROW(p, k0, 32 + sr) + 4); } while (0)
#define SWRITE_KF(bf) do { *(bf16x8*)(K_lds + (bf) * SHM_K + kws) = pack8(S.sf0, S.sf1); *(bf16x8*)(K_lds + (bf) * SHM_K + kws + 32 * 256) = pack8(S.sf2, S.sf3); } while (0)
#define SWRITE_VF(bf) do { *(bf16x8*)(V_lds + (bf) * SHM_V + vst0) = pack8(S.sf0, S.sf1); *(bf16x8*)(V_lds + (bf) * SHM_V + vst1) = pack8(S.sf2, S.sf3); } while (0)
template <class TIn, class TOut>
__device__ __forceinline__ void causal_swa_prime(const BlockRef<TIn, TOut>& cur, int W, char* lds, Seam<TIn>& S, const int tidv) {
    constexpr bool F32 = same_t<TIn, float>::v;
    const int tid = tidv, wid = __builtin_amdgcn_readfirstlane(tid >> 6), lane = tid & 63, r32 = lane & 31, hi = lane >> 5;
    const int sr = tid >> 4, sc = (tid & 15) * 8, kr8 = tid >> 3, kc8 = tid & 7, kws = kr8 * 128 + 16 * (kc8 ^ ((kr8 >> 1) & 7)); const unsigned kg8 = (unsigned)(kr8 * LDX + kc8 * 16); char* K_lds = lds + 2 * SHM_V;
    const int kb0 = swa_jlo(cur.P0, W) * KVBLK;
    for (int d0 = 0; d0 < 4; ++d0) S.qr[d0] = *(const bf16x8*)(cur.Q8 + (size_t)(wid * QBLK) * LDX + (unsigned)(r32 * LDX + hi * 16) + d0 * 32);
    if constexpr (F32) { SLOAD_F((const float*)cur.K, kb0); VMW(); SWRITE_KF(0); SBAR(); SLOAD_F((const float*)cur.V(), kb0); }
    else { SLOAD_H(cur.K8, cur.V(), kb0); VMW(); SWRITE_HK(0); }
    __syncthreads();
}
template <class TIn, class TOut>
__device__ __forceinline__ void causal_swa_block(const BlockRef<TIn, TOut>& cur, const BlockRef<TIn, TOut>& nxt, int skv, int W, char* lds, Seam<TIn>& S, const int tidv, float* RMAX) {
    constexpr bool F32 = same_t<TIn, float>::v;
    const int tid = tidv, wid = __builtin_amdgcn_readfirstlane(tid >> 6), lane = tid & 63, r32 = lane & 31, hi = lane >> 5;
    const int j_lo = swa_jlo(cur.P0, W);
    int j_hi = (cur.P0 + QB - 1) / KVBLK + 1; if (j_hi > skv / KVBLK) j_hi = skv / KVBLK;
    const int NT = j_hi - j_lo;
    const int kbn = swa_jlo(nxt.P0, W) * KVBLK;
    const int qlo = cur.P0 + wid * QBLK, qm = qlo + r32 - 4 * hi;
    char* V_lds = lds; char* K_lds = lds + 2 * SHM_V;
    float* ws = (float*)(lds + 2 * SHM_V + 2 * SHM_K) + wid * 64; float* li_l = ws, * al_l = ws + 32;
    const int* cbl = (const int*)(lds + CB_OFF);
    float m_reg = -1e30f, l_reg = 0; f32x16 o[4] = {};
    const int sr = tid >> 4, sc = (tid & 15) * 8, vst0 = v_st(sr, sc), vst1 = v_st(32 + sr, sc), kr8 = tid >> 3, kc8 = tid & 7, kws = kr8 * 128 + 16 * (kc8 ^ ((kr8 >> 1) & 7));
    const unsigned kg8 = (unsigned)(kr8 * LDX + kc8 * 16);
    const int vb0 = (int)(uintptr_t)V_lds + v_rd_base(lane);
    const unsigned char* Kh = cur.K8; const TIn* Vh = cur.V();
#define RESC(a) do { if (__any((a) < 1.f)) { if (hi == 0) al_l[r32] = (a); asm volatile("s_waitcnt lgkmcnt(0)" ::: "memory");              \
                     for (int d_ = 0; d_ < 4; ++d_) for (int r = 0; r < 16; ++r) o[d_][r] *= al_l[crow(r, hi)]; } } while (0)
#define KBASE(t) ((j_lo + (t)) * KVBLK)
#define ACT(t) (KBASE(t) <= qlo + QBLK - 1 && KBASE(t) + KVBLK - 1 >= qlo - W + 1)
#define MASKT(P0_, P1_, t) do { const int kb_ = KBASE(t); if ((!SK || ACT(t)) && (kb_ + KVBLK - 1 > qlo || kb_ <= qlo + QBLK - 1 - W)) mask_tile(P0_, P1_, qm - kb_, (unsigned)W); } while (0)
    constexpr int NQL = F32 ? 16 : 4;
    constexpr bool SK = WSKIP && !F32;
#define SEAM_K0() do { VMWN(NQL); if constexpr (F32) { SWRITE_KF(0); SBAR(); SLOAD_F((const float*)nxt.V(), kbn); } else { SWRITE_HK(0); } SBAR(); } while (0)
    f32x16 pA0, pA1, pB0, pB1; float mnA, mnB, alA, alB; bf16x8 pa0, pa1, pa2, pa3;
    if constexpr (F32) { VMW(); SWRITE_VF(0); SBAR(); } else { SWRITE_HV(0); SBAR(); }
    if (NT > 1) { if constexpr (F32) SLOAD_F((const float*)Kh, KBASE(1)); else SLOAD_H(Kh, Vh, KBASE(1)); }
    SBAR(); qkt<0, SK>(pA0, pA1, K_lds, r32, hi, S.qr, ACT(0), cbl + KBASE(0));
    if constexpr (F32) { if (NT > 1) { VMW(); SWRITE_KF(1); SBAR(); SLOAD_F((const float*)Vh, KBASE(1)); } }
    MASKT(pA0, pA1, 0); partialSM(pA0, pA1, m_reg, mnA, alA);
    if (NT > 1) { VMW(); if constexpr (F32) { SWRITE_VF(1); SBAR(); if (NT > 2) SLOAD_F((const float*)Kh, KBASE(2)); } else SWRITE_H(1); }
    __syncthreads();
#define HALF_STEP(PX0, PX1, mnX, alX, PY0, PY1, alY, t, KB, VB, SB) do {                                                      \
        SBAR(); qkt<KB, SK>(PX0, PX1, K_lds, r32, hi, S.qr, ACT(t), cbl + KBASE(t));                                             \
        finishSM(PY0, PY1, alY, l_reg, pa0, pa1, pa2, pa3); SBAR();                                                           \
        if ((t) + 1 < NT) { if constexpr (F32) { VMW(); SWRITE_KF(SB); SBAR(); SLOAD_F((const float*)Vh, KBASE((t) + 1)); }  \
                            else { SLOAD_H(Kh, Vh, KBASE((t) + 1)); } SBAR(); }                                               \
        pv_tile<VB, SK>(o, vb0, pa0, pa1, pa2, pa3, ACT((t) - 1)); MASKT(PX0, PX1, (t)); partialSM(PX0, PX1, m_reg, mnX, alX);                                        \
        __syncthreads();                                                                                                      \
        if ((t) + 1 < NT) { VMW(); if constexpr (F32) { SWRITE_VF(SB); SBAR(); if ((t) + 2 < NT) SLOAD_F((const float*)Kh, KBASE((t) + 2)); } \
                            else { SWRITE_H(SB); } }                                                                          \
        RESC(alX); __syncthreads(); } while (0)
    for (int t = 1; t + 1 < NT; t += 2) {
        HALF_STEP(pB0, pB1, mnB, alB, pA0, pA1, alA, t, 1, 0, 0);
        HALF_STEP(pA0, pA1, mnA, alA, pB0, pB1, alB, t + 1, 0, 1, 1);
    }
    const bool even = (NT & 1) == 0;
    if (even) { SBAR(); qkt<1, SK>(pB0, pB1, K_lds, r32, hi, S.qr, ACT(NT - 1), cbl + KBASE(NT - 1)); SBAR(); }
#define QROW(e) (nxt.Q + (size_t)(wid * QBLK + r32) * LDX + ((e) >> 1) * 16 + hi * 8 + ((e) & 1) * 4)
    if constexpr (F32) { SLOAD_F((const float*)nxt.K, kbn); SBAR();
#pragma unroll
        for (int e = 0; e < 8; ++e) S.tq[e] = *(const f32x4*)QROW(e); }
    else { SLOAD_H(nxt.K8, nxt.V(), kbn); SBAR();
#pragma unroll
        for (int d0 = 0; d0 < 4; ++d0) S.qr[d0] = *(const bf16x8*)(nxt.Q8 + (size_t)(wid * QBLK) * LDX + (unsigned)(r32 * LDX + hi * 16) + d0 * 32); }
    SBAR();
    finishSM(pA0, pA1, alA, l_reg, pa0, pa1, pa2, pa3); SBAR();
    if constexpr (F32) {
#pragma unroll
        for (int e = 8; e < 16; ++e) S.tq[e] = *(const f32x4*)QROW(e); SBAR(); }
#undef QROW
    pv_tile<0, SK>(o, vb0, pa0, pa1, pa2, pa3, ACT(even ? NT - 2 : NT - 1));
    if (even) { MASKT(pB0, pB1, NT - 1); partialSM(pB0, pB1, m_reg, mnB, alB); __syncthreads(); RESC(alB);
        finishSM(pB0, pB1, alB, l_reg, pa0, pa1, pa2, pa3); SBAR(); pv_tile<1, SK>(o, vb0, pa0, pa1, pa2, pa3, ACT(NT - 1)); }
    SBAR(); SEAM_K0();
    int r32e = r32, hie = hi; asm volatile("" : "+v"(r32e), "+v"(hie));
    if (hie == 0) li_l[r32e] = l_reg; asm volatile("s_waitcnt lgkmcnt(0)" ::: "memory");
    float rli[16];
#pragma unroll
    for (int r = 0; r < 16; ++r) rli[r] = __builtin_amdgcn_rcpf(li_l[crow(r, hie)]);
    TOut* Ow = cur.O() + (size_t)(wid * QBLK) * LDX;
#pragma unroll
    for (int r = 0; r < 16; ++r) { const int orow = crow(r, hie);
#pragma unroll
        for (int d0 = 0; d0 < 4; ++d0) { const float v = o[d0][r] * rli[r];
            const float vn = __shfl_xor(v, 1);
            if ((r32e & 1) == 0) *(unsigned*)(Ow + (size_t)orow * LDX + d0 * 32 + r32e) = cvtpk(v, vn); } }
    if constexpr (F32) {
#pragma unroll
        for (int d0 = 0; d0 < 8; ++d0) S.qr[d0] = pack8(S.tq[2 * d0], S.tq[2 * d0 + 1]); }
    __syncthreads();
#undef RESC
#undef KBASE
#undef ACT
#undef MASKT
#undef SEAM_K0
#undef HALF_STEP
}
#undef ROW
#undef VMW
#undef VMWN
#undef SLOAD_H
#undef SWRITE_HK
#undef SWRITE_HV
#undef SWRITE_H
#undef SLOAD_F
#undef SWRITE_KF
#undef SWRITE_VF

struct SwaItem { int bh, qb0, qb1; };
__device__ __forceinline__ SwaItem swa_decode(int L) {
    constexpr int nx = 8, nqb = 16;
    const int xcd = L & 7, k = L >> 3, gi = k / nx, x = k - gi * nx; SwaItem it; it.bh = gi * 8 + xcd;
    it.qb0 = x; it.qb1 = nqb - 1 - x; return it;
}
struct Tensors { const unsigned char* Q8; const unsigned char* K8; const bf16* V; bf16* O; const unsigned char* G; const float* CB; float* RMAX; };
__device__ __forceinline__ BlockRef<bf16, bf16> swa_ref(const SwaItem& it, int pass, const Tensors& T) {
    const int qb = pass ? it.qb1 : it.qb0, b = it.bh >> 4, h = it.bh & 15;
    const size_t qoff = ((size_t)b * 4096 + (size_t)qb * QB) * LDX + (size_t)h * D, koff = (size_t)b * 4096 * LDX + (size_t)h * D;
    BlockRef<bf16, bf16> r; r.Q8 = T.Q8 + qoff; r.K8 = T.K8 + koff; r.Vp = T.V + koff; r.Op = T.O + qoff; r.Gp = T.G + qoff; r.P0 = qb * QB; r.R0 = b * 4096 + qb * QB; r.HH = h; return r;
}
__device__ __forceinline__ void load_cb(char* lds, const float* CB, int bh, const int tid) {
    int t2 = tid; asm volatile("" : "+v"(t2)); const int tid_ = t2;
    const f32x4* src = (const f32x4*)(CB + (size_t)bh * 4096); f32x4* dst = (f32x4*)(lds + CB_OFF);
    const f32x4 a = src[tid_], b = src[tid_ + 512];
    dst[tid_] = a; dst[tid_ + 512] = b;
    __syncthreads();
}
__device__ __forceinline__ void attn_phase(char* lds, const Tensors& T, int grid, int bid, const int tidv) {
    constexpr int total = 1024, W = 4096, skv = 4096;
    int L = bid; if (L >= total) return;
    SwaItem it = swa_decode(L); int pass = 0;
    BlockRef<bf16, bf16> cur = swa_ref(it, 0, T);
    Seam<bf16> S;
    load_cb(lds, T.CB, it.bh, tidv);
    causal_swa_prime<bf16, bf16>(cur, W, lds, S, tidv);
    for (;;) {
        const bool more_pass = pass == 0 && it.qb1 != it.qb0, more_item = L + grid < total, last = !more_pass && !more_item;
        SwaItem itn = it; int passn = pass + 1, Ln = L;
        if (!more_pass) { passn = 0; Ln = more_item ? L + grid : L; itn = swa_decode(Ln); }
        const BlockRef<bf16, bf16> nxt = last ? cur : swa_ref(itn, passn, T);
        causal_swa_block<bf16, bf16>(cur, nxt, skv, W, lds, S, tidv, T.RMAX);
        if (last) break;
        cur = nxt; it = itn; pass = passn; L = Ln;
        if (pass == 0) load_cb(lds, T.CB, it.bh, tidv);
    }
}
#undef KSWZ
#undef SBAR
}

constexpr int NWAVES = 8;
constexpr int CW_TMO = 0, CW_CODE = 1;
constexpr int CW_BAR = 4096;
constexpr int RING_OFF = 0, RING_BYTES = 131072;
constexpr int AUX_OFF = RING_BYTES, AUX_BYTES = 20480;
constexpr int LDSCTL_OFF = AUX_OFF + AUX_BYTES, MISC_OFF = LDSCTL_OFF + 320;
constexpr int LDS_BYTES = LDSCTL_OFF + 1024;
static_assert(fox::LDS_TOTAL <= RING_BYTES && MISC_OFF + 128 <= LDS_BYTES, "LDS map");

#define GAS __attribute__((address_space(1)))
#define LAS __attribute__((address_space(3)))
typedef unsigned short bf16;
typedef unsigned v4u __attribute__((ext_vector_type(4)));
typedef unsigned v2u __attribute__((ext_vector_type(2)));
typedef int v4i __attribute__((ext_vector_type(4)));
typedef float f32x4 __attribute__((ext_vector_type(4)));
typedef float f32x16 __attribute__((ext_vector_type(16)));
typedef short bf16x8 __attribute__((ext_vector_type(8)));
typedef short s16x4 __attribute__((ext_vector_type(4)));
typedef short v4i16_t __attribute__((ext_vector_type(4)));
typedef GAS unsigned gu32;
#define RLX_AGENT __ATOMIC_RELAXED, __HIP_MEMORY_SCOPE_AGENT
#define LDS_WAIT() asm volatile("s_waitcnt lgkmcnt(0)" ::: "memory")
#define VM_WAIT() asm volatile("s_waitcnt vmcnt(0)" ::: "memory")
__device__ __forceinline__ unsigned f2bf(float f) { unsigned u = __builtin_bit_cast(unsigned, f); return (u + 0x7fffu + ((u >> 16) & 1u)) >> 16; }
__device__ __forceinline__ unsigned pk2(float lo, float hi) { return f2bf(lo) | (f2bf(hi) << 16); }

#define XB_TMO      128
#define XB_XCNT(j)  (256  + 64 * (j))
#define XB_XSUB(j)  (1280 + 64 * (j))
#define XB_XGEN(j)  (2304 + 64 * (j))
#define XB_TOP      3328
#define XB_TOPGEN   3392
#define XCD_BAR_WORDS 3456
#define XB_SPIN_CAP (1u << 18)

__device__ __forceinline__ unsigned xb_ld(unsigned* p)              { return __hip_atomic_load(p, __ATOMIC_RELAXED, __HIP_MEMORY_SCOPE_AGENT); }
__device__ __forceinline__ unsigned xb_add(unsigned* p, unsigned v) { return __hip_atomic_fetch_add(p, v, __ATOMIC_RELAXED, __HIP_MEMORY_SCOPE_AGENT); }
__device__ __forceinline__ unsigned xb_xcc_id() { return (unsigned)__builtin_amdgcn_s_getreg((3 << 11) | 20) & 0xFu; }
#define XB_SPIN(cond, bar) do { unsigned _sp = 0; while (cond) { __builtin_amdgcn_s_sleep(1); \
    if ((++_sp & 255u) == 0u) { if (xb_ld(&(bar)[XB_TMO])) break; if (_sp > XB_SPIN_CAP) { atomicAdd(&(bar)[XB_TMO], 1u); break; } } } } while (0)

struct XcdBarrier {
    unsigned* bar; unsigned x;
    volatile LAS unsigned* st;
};

__device__ __forceinline__ XcdBarrier xcd_barrier_post(unsigned* bar, volatile LAS unsigned* st, const bool leader  ) {
    XcdBarrier b; b.bar = bar; b.x = xb_xcc_id(); b.st = st;
    if (leader) (void)xb_add(&bar[XB_XCNT(b.x)], 1u);
    return b;
}
__device__ __forceinline__ void xcd_barrier_complete(unsigned* bar, unsigned x, unsigned& nloc, unsigned& nx) {
    const unsigned G = gridDim.x * gridDim.y * gridDim.z;
    unsigned sum, cnt, mine, sp = 0u;
    for (;;) {
        sum = 0u; cnt = 0u; mine = 0u;
#pragma unroll
        for (unsigned j = 0; j < 16; ++j) { const unsigned c = xb_ld(&bar[XB_XCNT(j)]); sum += c; cnt += (c > 0u) ? 1u : 0u; mine = (j == x) ? c : mine; }
        if (sum == G) break;
        __builtin_amdgcn_s_sleep(1);
        if ((++sp & 255u) == 0u) { if (xb_ld(&bar[XB_TMO])) break; if (sp > XB_SPIN_CAP) { atomicAdd(&bar[XB_TMO], 1u); break; } }
    }
    nloc = mine > 0u ? mine : 1u; nx = cnt > 0u ? cnt : 1u;
}

__device__ __forceinline__ void xcd_barrier(const XcdBarrier& b, const bool leader  ) {
    asm volatile("s_waitcnt vmcnt(0)" ::: "memory");
    __syncthreads();
    if (leader) {
        unsigned* bar = b.bar;
        __builtin_amdgcn_s_waitcnt(0);
        unsigned nloc = b.st[0], nx = b.st[1];
        if (nloc == 0u) { xcd_barrier_complete(bar, b.x, nloc, nx); b.st[0] = nloc; b.st[1] = nx; }
        const unsigned old = xb_add(&bar[XB_XSUB(b.x)], 1u);
        const unsigned gen = old / nloc;
        if (old + 1u == (gen + 1u) * nloc) {
            __builtin_amdgcn_fence(__ATOMIC_RELEASE, "agent");
            asm volatile("s_waitcnt vmcnt(0)" ::: "memory");
            const unsigned og = xb_add(&bar[XB_TOP], 1u);
            const unsigned tg = og / nx;
            if (og + 1u == (tg + 1u) * nx) xb_add(&bar[XB_TOPGEN], 1u);
            else XB_SPIN(xb_ld(&bar[XB_TOPGEN]) == tg, bar);
            __builtin_amdgcn_fence(__ATOMIC_ACQUIRE, "agent");
            xb_add(&bar[XB_XGEN(b.x)], 1u);
            asm volatile("s_waitcnt vmcnt(0)" ::: "memory");
        } else {
            XB_SPIN(xb_ld(&bar[XB_XGEN(b.x)]) == gen, bar);
            __builtin_amdgcn_fence(__ATOMIC_ACQUIRE, "agent");
            asm volatile("s_waitcnt vmcnt(0)" ::: "memory");
        }
    }
    __syncthreads();
}


__device__ __forceinline__ float wave_sum(float v) {
#pragma unroll
    for (int o = 1; o < 64; o <<= 1) v += __shfl_xor(v, o);
    return v;
}
__device__ __forceinline__ void tr_item(const float* W, int K, int Nsrc, int src_col0, int lim, bf16* WT, int dst_row0, int nblk, LAS float* scr, int item, int lane, const float* gain  ) {
    const int kb = item / nblk, nb = item % nblk, k0 = 64 * kb, n0 = 32 * nb, col = src_col0 + n0 + (lane & 31);
    float wv[32];
#pragma unroll
    for (int i = 0; i < 32; ++i) { const int kk = 2 * i + (lane >> 5); wv[i] = col < lim ? W[(size_t)(k0 + kk) * Nsrc + col] : 0.f; }
#pragma unroll
    for (int i = 0; i < 32; ++i) { const int kk = 2 * i + (lane >> 5); const float gk = gain ? gain[k0 + kk] : 1.0f; scr[kk * 33 + (lane & 31)] = wv[i] * gk; }
    LDS_WAIT(); asm volatile("" ::: "memory");
    const int c = lane & 7;
#pragma unroll
    for (int j = 0; j < 4; ++j) { const int n = (lane >> 3) + 8 * j; const LAS float* s = scr + (8 * c) * 33 + n;
        v4u o; o.x = pk2(s[0 * 33], s[1 * 33]); o.y = pk2(s[2 * 33], s[3 * 33]); o.z = pk2(s[4 * 33], s[5 * 33]); o.w = pk2(s[6 * 33], s[7 * 33]);
        *(GAS v4u*)(WT + (size_t)(dst_row0 + n0 + n) * K + k0 + 8 * c) = o; }
    LDS_WAIT(); asm volatile("" ::: "memory");
}
__device__ __forceinline__ unsigned pk4_fp8(float a, float b, float c, float d) { int w = 0; w = __builtin_amdgcn_cvt_pk_fp8_f32(a, b, w, false); w = __builtin_amdgcn_cvt_pk_fp8_f32(c, d, w, true); return (unsigned)w; }
__device__ __forceinline__ void tr_item_f8(const float* W, int K, int Nsrc, int src_col0, int lim, unsigned char* WT, int dst_row0, int nblk, LAS float* scr, int item, int lane, float scale) {
    const int kb = item / nblk, nb = item % nblk, k0 = 64 * kb, n0 = 32 * nb, col = src_col0 + n0 + (lane & 31);
#pragma unroll 8
    for (int i = 0; i < 32; ++i) { const int kk = 2 * i + (lane >> 5); scr[kk * 33 + (lane & 31)] = col < lim ? W[(size_t)(k0 + kk) * Nsrc + col] * scale : 0.f; }
    LDS_WAIT(); asm volatile("" ::: "memory");
    const int c = lane & 7;
#pragma unroll
    for (int j = 0; j < 4; ++j) { const int n = (lane >> 3) + 8 * j; const LAS float* s = scr + (8 * c) * 33 + n;
        v2u o; o.x = pk4_fp8(s[0 * 33], s[1 * 33], s[2 * 33], s[3 * 33]); o.y = pk4_fp8(s[4 * 33], s[5 * 33], s[6 * 33], s[7 * 33]);
        *(GAS v2u*)(WT + (size_t)(dst_row0 + n0 + n) * K + k0 + 8 * c) = o; }
    LDS_WAIT(); asm volatile("" ::: "memory");
}
__device__ __forceinline__ void colmax_item(const float* W, int Nsrc, int src_col0, int lim, unsigned* cmax, int dst_row0, int nblk, int item, int lane, const float* gain) {
    const int kb = item / nblk, nb = item % nblk, k0 = 64 * kb, n0 = 32 * nb, col = src_col0 + n0 + (lane & 31);
    float m = 0.f;
    if (col < lim) {
        float wv[32];
#pragma unroll
        for (int i = 0; i < 32; ++i) { const int kk = k0 + 2 * i + (lane >> 5); wv[i] = W[(size_t)kk * Nsrc + col]; }
#pragma unroll
        for (int i = 0; i < 32; ++i) { const int kk = k0 + 2 * i + (lane >> 5); m = fmaxf(m, fabsf(wv[i] * (gain ? gain[kk] : 1.0f))); }
    }
    m = fmaxf(m, __shfl_xor(m, 32));
    if (lane < 32) atomicMax(cmax + dst_row0 + n0 + lane, __float_as_uint(m));
}
__device__ __forceinline__ void tr_item_i8(const float* W, int K, int Nsrc, int src_col0, int lim, unsigned char* WT, int dst_row0, int nblk, LAS float* scr, int item, int lane, const float* gain  , const unsigned* cmax, float* CS, const float act_inv  ) {
    const int kb = item / nblk, nb = item % nblk, k0 = 64 * kb, n0 = 32 * nb, col = src_col0 + n0 + (lane & 31);
    const float cm = __uint_as_float(cmax[dst_row0 + n0 + (lane & 31)]), qs = cm > 0.f ? 127.0f / cm : 0.f;
    if (kb == 0 && lane < 32) CS[dst_row0 + n0 + lane] = cm * (1.0f / 127.0f) * act_inv;
    float wv[32];
#pragma unroll
    for (int i = 0; i < 32; ++i) { const int kk = 2 * i + (lane >> 5); wv[i] = col < lim ? W[(size_t)(k0 + kk) * Nsrc + col] : 0.f; }
#pragma unroll
    for (int i = 0; i < 32; ++i) { const int kk = 2 * i + (lane >> 5); scr[kk * 33 + (lane & 31)] = wv[i] * (gain ? gain[k0 + kk] : 1.0f) * qs; }
    LDS_WAIT(); asm volatile("" ::: "memory");
    const int c = lane & 7;
#pragma unroll
    for (int j = 0; j < 4; ++j) { const int n = (lane >> 3) + 8 * j; const LAS float* s = scr + (8 * c) * 33 + n;
        v2u o;
#define Q8(x) ((unsigned)((int)__builtin_rintf(fminf(fmaxf((x), -127.f), 127.f)) & 255))
        o.x = Q8(s[0 * 33]) | (Q8(s[1 * 33]) << 8) | (Q8(s[2 * 33]) << 16) | (Q8(s[3 * 33]) << 24); o.y = Q8(s[4 * 33]) | (Q8(s[5 * 33]) << 8) | (Q8(s[6 * 33]) << 16) | (Q8(s[7 * 33]) << 24);
#undef Q8
        *(GAS v2u*)(WT + (size_t)(dst_row0 + n0 + n) * K + k0 + 8 * c) = o; }
    LDS_WAIT(); asm volatile("" ::: "memory");
}
__device__ __forceinline__ void rms_row_to_fp8(const float* xrow, const float* g, unsigned char* orow, int lane) {
    const GAS f32x4* xr = (const GAS f32x4*)xrow + lane; const GAS f32x4* gr = (const GAS f32x4*)g + lane;
    f32x4 v[8]; float s = 0.f;
#pragma unroll
    for (int j = 0; j < 8; ++j) { v[j] = xr[64 * j]; s += (v[j].x * v[j].x + v[j].y * v[j].y) + (v[j].z * v[j].z + v[j].w * v[j].w); }
    const float r = 1.0f / sqrtf(wave_sum(s) * (1.f / 2048.f) + EPS);
    GAS unsigned* o4 = (GAS unsigned*)orow + lane;
#pragma unroll
    for (int j = 0; j < 8; ++j) { const f32x4 gg = gr[64 * j]; o4[64 * j] = pk4_fp8(v[j].x * r * gg.x, v[j].y * r * gg.y, v[j].z * r * gg.z, v[j].w * r * gg.w); }
}
__device__ __forceinline__ void rms_row_to_bf16(const float* xrow, const float* g, bf16* orow, int lane) {
    const GAS f32x4* xr = (const GAS f32x4*)xrow + lane; const GAS f32x4* gr = (const GAS f32x4*)g + lane;
    f32x4 v[8]; float s = 0.f;
#pragma unroll
    for (int j = 0; j < 8; ++j) { v[j] = xr[64 * j]; s += (v[j].x * v[j].x + v[j].y * v[j].y) + (v[j].z * v[j].z + v[j].w * v[j].w); }
    const float r = 1.0f / sqrtf(wave_sum(s) * (1.f / 2048.f) + EPS);
    GAS v2u* o8 = (GAS v2u*)orow + lane;
#pragma unroll
    for (int j = 0; j < 8; ++j) { const f32x4 gg = gr[64 * j]; v2u o; o.x = pk2(v[j].x * r * gg.x, v[j].y * r * gg.y); o.y = pk2(v[j].z * r * gg.z, v[j].w * r * gg.w); o8[64 * j] = o; }
}
__device__ __forceinline__ float row_to_bf16_ss(const float* xrow, bf16* orow, unsigned char* qrow, int lane) {
    const GAS f32x4* xr = (const GAS f32x4*)xrow + lane; GAS v2u* o8 = (GAS v2u*)orow + lane; GAS unsigned* q4 = (GAS unsigned*)qrow + lane; float s = 0.f;
#pragma unroll
    for (int j = 0; j < 8; ++j) { const f32x4 v = xr[64 * j]; s += (v.x * v.x + v.y * v.y) + (v.z * v.z + v.w * v.w); v2u o; o.x = pk2(v.x, v.y); o.y = pk2(v.z, v.w); o8[64 * j] = o; q4[64 * j] = pg8::q8x4(v); }
    return wave_sum(s);
}
template <int NP  >
__device__ __forceinline__ void requant_row(bf16* xrow, const float* rmp, float* rs, int lane) {
    const GAS v4u* xr = (const GAS v4u*)xrow + lane;
    v4u v[4];
#pragma unroll
    for (int j = 0; j < 4; ++j) v[j] = xr[64 * j];
    float mxv = lane < NP ? rmp[lane] : 0.f;
#pragma unroll
    for (int o = 1; o < NP; o <<= 1) mxv = fmaxf(mxv, __shfl_xor(mxv, o));
    mxv = __builtin_amdgcn_readfirstlane(__float_as_uint(mxv)) ? __uint_as_float(__builtin_amdgcn_readfirstlane(__float_as_uint(mxv))) : 0.f;
    const float q = mxv > 0.f ? 127.0f / mxv : 0.f;
    asm volatile("s_waitcnt vmcnt(0)" ::: "memory");
    GAS v2u* o8 = (GAS v2u*)xrow + lane;
#pragma unroll
    for (int j = 0; j < 4; ++j) {
#define RQ(u_, sh_) ((unsigned)((int)__builtin_rintf(fminf(fmaxf(__uint_as_float(((u_) >> (sh_)) << 16) * q, -127.f), 127.f)) & 255))
        v2u o; o.x = RQ(v[j].x, 0) | (RQ(v[j].x, 16) << 8) | (RQ(v[j].y, 0) << 16) | (RQ(v[j].y, 16) << 24); o.y = RQ(v[j].z, 0) | (RQ(v[j].z, 16) << 8) | (RQ(v[j].w, 0) << 16) | (RQ(v[j].w, 16) << 24);
#undef RQ
        o8[64 * j] = o; }
    if (lane == 0) *rs = mxv * (1.0f / 127.0f);
}
__device__ __forceinline__ void requant_row_gate(bf16* xrow, const unsigned char* grow, float* rs, int lane) {
    const GAS v4u* xr = (const GAS v4u*)xrow + lane; const GAS v2u* gr = (const GAS v2u*)grow + lane;
    v4u v[4]; v2u g[4];
#pragma unroll
    for (int j = 0; j < 4; ++j) { v[j] = xr[64 * j]; g[j] = gr[64 * j]; }
    asm volatile("s_waitcnt vmcnt(0)" ::: "memory");
    float f[4][8]; float mxv = 0.f;
#pragma unroll
    for (int j = 0; j < 4; ++j) {
#define GB(w_, i_) ((float)((int)((w_) << (24 - 8 * (i_))) >> 24) * 0.0625f)
        f[j][0] = __uint_as_float(v[j].x << 16) * GB(g[j].x, 0); f[j][1] = __uint_as_float(v[j].x & 0xffff0000u) * GB(g[j].x, 1); f[j][2] = __uint_as_float(v[j].y << 16) * GB(g[j].x, 2); f[j][3] = __uint_as_float(v[j].y & 0xffff0000u) * GB(g[j].x, 3);
        f[j][4] = __uint_as_float(v[j].z << 16) * GB(g[j].y, 0); f[j][5] = __uint_as_float(v[j].z & 0xffff0000u) * GB(g[j].y, 1); f[j][6] = __uint_as_float(v[j].w << 16) * GB(g[j].y, 2); f[j][7] = __uint_as_float(v[j].w & 0xffff0000u) * GB(g[j].y, 3);
#undef GB
#pragma unroll
        for (int e = 0; e < 8; ++e) mxv = fmaxf(mxv, fabsf(f[j][e])); }
#pragma unroll
    for (int o = 1; o < 64; o <<= 1) mxv = fmaxf(mxv, __shfl_xor(mxv, o));
    const float q = mxv > 0.f ? 127.0f / mxv : 0.f;
    GAS v2u* o8 = (GAS v2u*)xrow + lane;
#pragma unroll
    for (int j = 0; j < 4; ++j) {
#define RQ(x_) ((unsigned)((int)__builtin_rintf((x_) * q) & 255))
        v2u o; o.x = RQ(f[j][0]) | (RQ(f[j][1]) << 8) | (RQ(f[j][2]) << 16) | (RQ(f[j][3]) << 24); o.y = RQ(f[j][4]) | (RQ(f[j][5]) << 8) | (RQ(f[j][6]) << 16) | (RQ(f[j][7]) << 24);
#undef RQ
        o8[64 * j] = o; }
    if (lane == 0) *rs = mxv * (1.0f / 127.0f);
}
__device__ __forceinline__ void rms_row_final(const bf16* xrow, const float* ssp, float* orow, const float* g, int lane) {
    const f32x4 s0 = *(const f32x4*)ssp, s1 = *(const f32x4*)(ssp + 4);
    const float r = 1.0f / sqrtf((((s0[0] + s0[1]) + (s0[2] + s0[3])) + ((s1[0] + s1[1]) + (s1[2] + s1[3]))) * (1.f / 2048.f) + EPS);
    const GAS v4u* xr = (const GAS v4u*)xrow + lane; GAS f32x4* orr = (GAS f32x4*)orow + 2 * lane; const GAS f32x4* gr = (const GAS f32x4*)g + 2 * lane;
#pragma unroll
    for (int j = 0; j < 4; ++j) { const v4u v = xr[64 * j]; const f32x4 g0 = gr[128 * j], g1 = gr[128 * j + 1];
        orr[128 * j] = (f32x4){__uint_as_float(v.x << 16) * r * g0.x, __uint_as_float(v.x & 0xffff0000u) * r * g0.y, __uint_as_float(v.y << 16) * r * g0.z, __uint_as_float(v.y & 0xffff0000u) * r * g0.w};
        orr[128 * j + 1] = (f32x4){__uint_as_float(v.z << 16) * r * g1.x, __uint_as_float(v.z & 0xffff0000u) * r * g1.y, __uint_as_float(v.w << 16) * r * g1.z, __uint_as_float(v.w & 0xffff0000u) * r * g1.w}; }
}
__device__ __forceinline__ void rms_row_f32(const float* xrow, float* orow, const float* g, int lane) {
    const GAS f32x4* xr = (const GAS f32x4*)xrow + lane; GAS f32x4* orr = (GAS f32x4*)orow + lane; const GAS f32x4* gr = (const GAS f32x4*)g + lane;
    f32x4 v[8]; float s = 0.f;
#pragma unroll
    for (int j = 0; j < 8; ++j) { v[j] = xr[64 * j]; s += (v[j].x * v[j].x + v[j].y * v[j].y) + (v[j].z * v[j].z + v[j].w * v[j].w); }
    const float r = 1.0f / sqrtf(wave_sum(s) * (1.f / 2048.f) + EPS);
#pragma unroll
    for (int j = 0; j < 8; ++j) { const f32x4 gg = gr[64 * j]; orr[64 * j] = (f32x4){v[j].x * r * gg.x, v[j].y * r * gg.y, v[j].z * r * gg.z, v[j].w * r * gg.w}; }
}
__device__ __forceinline__ void cq_row(const float* raw, const float* qn, const float* kn, bf16* cq, bf16* ckv, int lane) {
    const GAS f32x4* xr = (const GAS f32x4*)raw + lane;
    const f32x4 a0 = xr[0], a1 = xr[64], c0 = xr[128];
    const float sq = wave_sum((a0.x * a0.x + a0.y * a0.y) + (a0.z * a0.z + a0.w * a0.w) + (a1.x * a1.x + a1.y * a1.y) + (a1.z * a1.z + a1.w * a1.w));
    const float sk = wave_sum((c0.x * c0.x + c0.y * c0.y) + (c0.z * c0.z + c0.w * c0.w));
    const float rq = 1.0f / sqrtf(sq * (1.f / 512.f) + EPS), rk = 1.0f / sqrtf(sk * (1.f / 256.f) + EPS);
    const f32x4 g0 = ((const GAS f32x4*)qn)[lane], g1 = ((const GAS f32x4*)qn)[lane + 64], gk = ((const GAS f32x4*)kn)[lane];
    v2u o; o.x = pk2(a0.x * rq * g0.x, a0.y * rq * g0.y); o.y = pk2(a0.z * rq * g0.z, a0.w * rq * g0.w); ((GAS v2u*)cq)[lane] = o;
    o.x = pk2(a1.x * rq * g1.x, a1.y * rq * g1.y); o.y = pk2(a1.z * rq * g1.z, a1.w * rq * g1.w); ((GAS v2u*)cq)[lane + 64] = o;
    o.x = pk2(c0.x * rk * gk.x, c0.y * rk * gk.y); o.y = pk2(c0.z * rk * gk.z, c0.w * rk * gk.w); ((GAS v2u*)ckv)[lane] = o;
}

__device__ __forceinline__ void fpre_stage(LAS unsigned char* wl, const unsigned char* W8, int tid) {
    typedef int v4i32_ __attribute__((ext_vector_type(4)));
#pragma unroll
    for (int q = 0; q < 4; ++q) { const int idx = q * 512 + tid, row = idx >> 7, ch = idx & 127; *(LAS v4i32_*)(wl + row * 2064 + ch * 16) = *(const GAS v4i32_*)(W8 + (size_t)idx * 16); }
}
__device__ __forceinline__ void fpre_rows(const LAS unsigned char* wl, const unsigned char* A8, const float* SS, const float* CS, const float* fbias, float* LF, int row0, int lane, bool first) {
    typedef int v4i32_ __attribute__((ext_vector_type(4)));
    const int i = lane & 15, g = lane >> 4;
    const unsigned char* ap = A8 + (size_t)(row0 + i) * 2048 + 16 * g;
    v4i32_ af[32];
#pragma unroll
    for (int s = 0; s < 32; ++s) af[s] = *(const GAS v4i32_*)(ap + 64 * s);
    f32x4 ss[4][2];
#pragma unroll
    for (int e = 0; e < 4; ++e) { const f32x4* sp = (const f32x4*)(SS + (size_t)(row0 + 4 * g + e) * 8); ss[e][0] = sp[0]; ss[e][1] = sp[1]; }
    const float cs = CS[i], fb = fbias[i];
    if (first) __syncthreads();
    const LAS unsigned char* bp = wl + i * 2064 + 16 * g;
    v4i32_ acc = (v4i32_){0, 0, 0, 0};
#pragma unroll
    for (int s = 0; s < 32; ++s) acc = __builtin_amdgcn_mfma_i32_16x16x64_i8(af[s], *(const LAS v4i32_*)(bp + 64 * s), acc, 0, 0, 0);
#pragma unroll
    for (int e = 0; e < 4; ++e) {
        const f32x4 s0 = ss[e][0], s1 = ss[e][1];
        const float rf = __builtin_amdgcn_rsqf(((((s0[0] + s0[1]) + (s0[2] + s0[3])) + ((s1[0] + s1[1]) + (s1[2] + s1[3])))) * (1.0f / 2048.0f) + 1e-6f);
        const float x = (float)acc[e] * (cs * rf) + fb;
        LF[(size_t)(row0 + 4 * g + e) * 16 + i] = fminf(x, 0.f) - __logf(1.0f + __expf(-fabsf(x)));
    }
}

__device__ __forceinline__ unsigned ord_key(float f) { const unsigned u = __float_as_uint(f); return u ^ ((unsigned)((int)u >> 31) | 0x80000000u); }
__device__ __forceinline__ int mbcnt64(unsigned long long m) { return __builtin_amdgcn_mbcnt_hi((unsigned)(m >> 32), __builtin_amdgcn_mbcnt_lo((unsigned)m, 0u)); }
__device__ __forceinline__ unsigned long long cmp_ge_mask(unsigned key, unsigned cand) { unsigned long long m; asm("v_cmp_ge_u32_e64 %0, %1, %2" : "=s"(m) : "v"(key), "s"(cand)); return m; }
__device__ __forceinline__ unsigned long long cmp_lt_mask(unsigned a, unsigned b) { unsigned long long m; asm("v_cmp_lt_u32_e64 %0, %1, %2" : "=s"(m) : "v"(a), "s"(b)); return m; }
__device__ __forceinline__ int sel_pos(unsigned long long m, int base, int dump) { const int p = base + mbcnt64(m); int r; asm("v_cndmask_b32_e64 %0, %1, %2, %3" : "=v"(r) : "v"(dump), "v"(p), "s"(m)); return r; }
template <int NV>
__device__ __forceinline__ void topk_select(const LAS unsigned* sc, int t, int lane, int* out, unsigned& gpre  ) {
    { int l_ = lane; asm volatile("" : "+v"(l_)); lane = l_; }
    unsigned key[NV];
    const int tl = t - lane;
#pragma unroll
    for (int i = 0; i < NV; ++i) { const unsigned v = sc[i * 64 + lane]; key[i] = (tl >= i * 64) ? v : 0u; }
    unsigned T = 0u;
    constexpr int NC = 8;
    int cntT = 64 * NV, nabove = 0, bit = 31; bool done = false;
#define TS_COUNT(cnt_, cand_) do { cnt_ = 0; \
        _Pragma("unroll") for (int i0 = 0; i0 < NV; i0 += 8) { unsigned long long mk[8]; \
            _Pragma("unroll") for (int j = 0; j < 8; ++j) mk[j] = cmp_ge_mask(key[i0 + j], cand_); \
            __builtin_amdgcn_sched_barrier(0); \
            _Pragma("unroll") for (int j = 0; j < 8; ++j) cnt_ += __builtin_popcountll(mk[j]); \
            __builtin_amdgcn_sched_barrier(0); } } while (0)
    if (gpre != 0u && gpre < 0xff000000u) {
        unsigned g = gpre; int c0, c1;
        TS_COUNT(c0, g);
        if (c0 >= TOPK) { const unsigned g1 = g + (1u << 23); TS_COUNT(c1, g1); if (c1 >= TOPK && g1 < 0xff000000u) { g = g1; c0 = c1; const unsigned g2 = g1 + (1u << 23); TS_COUNT(c1, g2); } }
        else if (g >= (2u << 23)) { c1 = c0; g -= (1u << 23); TS_COUNT(c0, g); }
        else { c1 = TOPK; }
        if (c0 >= TOPK && c1 < TOPK) { T = g; cntT = c0; nabove = c1; bit = 22; done = c0 == TOPK; }
    }
    for (; !done && bit >= 0; --bit) {
        const unsigned cand = T | (1u << bit); int cnt;
        TS_COUNT(cnt, cand);
        if (cnt >= TOPK) { T = cand; cntT = cnt; if (cnt == TOPK) { done = true; break; } } else nabove = cnt;
        if (NV > NC && bit >= 6 && cntT - nabove <= 64 * NC) { --bit; break; }
    }
    if (NV > NC && !done && bit >= 0) {
        LAS unsigned* lst = (LAS unsigned*)sc;
        const unsigned width = 2u << bit; int base = 0;
#pragma unroll
        for (int i0 = 0; i0 < NV; i0 += 8) {
            unsigned long long mk[8];
#pragma unroll
            for (int j = 0; j < 8; ++j) mk[j] = cmp_lt_mask(key[i0 + j] - T, width);
            __builtin_amdgcn_sched_barrier(0);
#pragma unroll
            for (int j = 0; j < 8; ++j) { lst[sel_pos(mk[j], base, 1024 + lane)] = key[i0 + j]; base += __builtin_popcountll(mk[j]); }
            __builtin_amdgcn_sched_barrier(0);
        }
        unsigned ck[NC];
#pragma unroll
        for (int i = 0; i < NC; ++i) { const unsigned v = lst[i * 64 + lane]; ck[i] = (i * 64 + lane < base) ? v : 0u; }
        const int need = TOPK - nabove;
        for (; bit >= 0; --bit) {
            const unsigned cand = T | (1u << bit); int cnt = 0;
            unsigned long long mk[NC];
#pragma unroll
            for (int i = 0; i < NC; ++i) mk[i] = cmp_ge_mask(ck[i], cand);
            __builtin_amdgcn_sched_barrier(0);
#pragma unroll
            for (int i = 0; i < NC; ++i) cnt += __builtin_popcountll(mk[i]);
            if (cnt >= need) { T = cand; if (cnt == need) { done = true; break; } }
        }
    }
    gpre = T & 0xff800000u;
#undef TS_COUNT
    LAS int* ol = (LAS int*)sc + 2048;
    int base = 0;
    if (done) {
#pragma unroll
        for (int i0 = 0; i0 < NV; i0 += 8) {
            unsigned long long mk[8];
#pragma unroll
            for (int j = 0; j < 8; ++j) mk[j] = cmp_ge_mask(key[i0 + j], T);
            __builtin_amdgcn_sched_barrier(0);
#pragma unroll
            for (int j = 0; j < 8; ++j) { ol[sel_pos(mk[j], base, TOPK + lane)] = (i0 + j) * 64 + lane; base += __builtin_popcountll(mk[j]); }
            __builtin_amdgcn_sched_barrier(0);
        }
    } else {
#pragma unroll
    for (int i = 0; i < NV; ++i) {
        const bool gt = key[i] > T; const unsigned long long m = __ballot(gt);
        if (gt) ol[base + mbcnt64(m)] = i * 64 + lane;
        base += __builtin_popcountll(m);
        if ((i & 3) == 3) __builtin_amdgcn_sched_barrier(0);
    }
#pragma unroll
    for (int i = 0; i < NV; ++i) {
        const bool eq = key[i] == T; const unsigned long long m = __ballot(eq);
        const int pos = base + mbcnt64(m);
        if (eq && pos < TOPK) ol[pos] = i * 64 + lane;
        base += __builtin_popcountll(m);
        if ((i & 3) == 3) __builtin_amdgcn_sched_barrier(0);
    }
    }
    const v4i r4 = ((const LAS v4i*)ol)[lane];
    *(v4i*)(out + 4 * lane) = r4;
}
__device__ __forceinline__ void topk_phase(LAS unsigned char* lds, const bf16* QI, const bf16* IK, const float* IW, int* IDX, int G, int bid, int wave, int lane, const int mode  ) {
    LAS unsigned* sc = (LAS unsigned*)lds;
    const int i31 = lane & 31, kh = lane >> 5;
    const int headA = (i31 & 3) + 4 * (i31 >> 3), qsel = (i31 >> 2) & 1;
    const int mh = wave >> 2, kw = wave & 3;
    bf16x8 a[2][4]; f32x4 w[2][4];
#define TK_LOAD_AW(it_) do { const size_t r0_ = (size_t)((it_) & 7) * SEQ + (size_t)((it_) >> 3) * 8; \
        _Pragma("unroll") for (int m = 0; m < 2; ++m) { \
            _Pragma("unroll") for (int s = 0; s < 4; ++s) a[m][s] = *(const bf16x8*)(QI + (r0_ + 4 * mh + 2 * m + qsel) * NQI + 4096 + headA * 64 + 16 * s + 8 * kh); \
            _Pragma("unroll") for (int g4 = 0; g4 < 4; ++g4) w[m][g4] = *(const f32x4*)(IW + (r0_ + 4 * mh + 2 * m + kh) * 16 + 4 * g4); } } while (0)
    unsigned gpre = 0u;
    if (bid < M / 8) TK_LOAD_AW(bid);
    for (int item = bid; item < M / 8; item += G) {
        const int b = item & 7, t0 = (item >> 3) * 8; const size_t row0 = (size_t)b * SEQ + t0;
        if ((mode & 1) && t0 + 8 > TOPK) {
            const int ntiles = (t0 + 8 + 31) >> 5;
            const int nti = (ntiles - kw + 3) >> 2;
            const bf16* ikb = IK + (size_t)b * SEQ * 64 + (size_t)lane * 8;
#define TK_LOAD(dst, i_) do { int kt_ = kw + 4 * (i_); kt_ = kt_ < ntiles ? kt_ : ntiles - 1; \
                _Pragma("unroll") for (int s = 0; s < 4; ++s) dst[s] = *(const bf16x8*)(ikb + (size_t)kt_ * 2048 + 512 * s); } while (0)
#define TK_COMP(src, i_) do { const int kt_ = kw + 4 * (i_); if (kt_ < ntiles) { \
                _Pragma("unroll") for (int m = 0; m < 2; ++m) { f32x16 acc = {}; \
                    _Pragma("unroll") for (int s = 0; s < 4; ++s) acc = __builtin_amdgcn_mfma_f32_32x32x16_bf16(a[m][s], src[s], acc, 0, 0, 0); \
                    float sv = 0.f; \
                    _Pragma("unroll") for (int r = 0; r < 16; ++r) { const int ai_ = __float_as_int(acc[r]); sv = fmaf(__int_as_float(ai_ > 0 ? ai_ : 0), w[m][r >> 2][r & 3], sv); }     \
                    sc[(4 * mh + 2 * m + kh) * 4096 + kt_ * 32 + i31] = ord_key(sv); } } } while (0)
            bf16x8 b0[4], b1[4], b2[4], b3[4];
            TK_LOAD(b0, 0); TK_LOAD(b1, 1); TK_LOAD(b2, 2);
            for (int i = 0; i < nti; i += 4) {
                TK_LOAD(b3, i + 3); TK_COMP(b0, i);
                TK_LOAD(b0, i + 4); TK_COMP(b1, i + 1);
                TK_LOAD(b1, i + 5); TK_COMP(b2, i + 2);
                TK_LOAD(b2, i + 6); TK_COMP(b3, i + 3);
            }
#undef TK_LOAD
#undef TK_COMP
        }
        if (item + G < M / 8) TK_LOAD_AW(item + G);
        __syncthreads();
        if (mode & 2) {
            const int t = t0 + wave; int* out = IDX + (row0 + wave) * TOPK; const LAS unsigned* scq = sc + wave * 4096;
            if (t < TOPK) {
#pragma unroll
                for (int i = 0; i < 4; ++i) { const int s = i * 64 + lane; out[s] = s <= t ? s : 0; }
            } else if (t0 + 8 <= 512) topk_select<8>(scq, t, lane, out, gpre);
            else if (t0 + 8 <= 1024) topk_select<16>(scq, t, lane, out, gpre);
            else if (t0 + 8 <= 1536) topk_select<24>(scq, t, lane, out, gpre);
            else if (t0 + 8 <= 2048) topk_select<32>(scq, t, lane, out, gpre);
            else if (t0 + 8 <= 2560) topk_select<40>(scq, t, lane, out, gpre);
            else if (t0 + 8 <= 3072) topk_select<48>(scq, t, lane, out, gpre);
            else if (t0 + 8 <= 3584) topk_select<56>(scq, t, lane, out, gpre);
            else topk_select<64>(scq, t, lane, out, gpre);
        }
        __syncthreads();
    }
#undef TK_LOAD_AW
}

__device__ __forceinline__ int t5_bucket(int d) {
    if (d < 16) return d;
    const float v = logf((float)d / 16.0f) / 2.0794415416798357f * 16.0f;
    int l = 16 + (int)v; return l < 31 ? l : 31;
}
__device__ __forceinline__ s16x4 tr_read(const LAS unsigned char* p) { return __builtin_bit_cast(s16x4, __builtin_amdgcn_ds_read_tr16_b64_v4i16((LAS v4i16_t*)p)); }
__device__ __forceinline__ unsigned cvtpk(float lo, float hi) { unsigned r; asm volatile("v_cvt_pk_bf16_f32 %0, %1, %2" : "=v"(r) : "v"(lo), "v"(hi)); return r; }
__device__ __forceinline__ float xor16_max(float x) { const unsigned u = __float_as_uint(x); const auto r = __builtin_amdgcn_permlane16_swap(u, u, false, false); return fmaxf(__uint_as_float(r[0]), __uint_as_float(r[1])); }
__device__ __forceinline__ float xor32_max(float x) { const unsigned u = __float_as_uint(x); const auto r = __builtin_amdgcn_permlane32_swap(u, u, false, false); return fmaxf(__uint_as_float(r[0]), __uint_as_float(r[1])); }
__device__ __forceinline__ float xor16_sum(float x) { const unsigned u = __float_as_uint(x); const auto r = __builtin_amdgcn_permlane16_swap(u, u, false, false); return __uint_as_float(r[0]) + __uint_as_float(r[1]); }
__device__ __forceinline__ float xor32_sum(float x) { const unsigned u = __float_as_uint(x); const auto r = __builtin_amdgcn_permlane32_swap(u, u, false, false); return __uint_as_float(r[0]) + __uint_as_float(r[1]); }
__device__ __forceinline__ void sparse_phase(LAS unsigned char* lds, bf16* QI, const bf16* CKV, const int* IDX, const float* rel_bias, float* RSU  , int G, int bid, int wave, int lane, int tid, bf16* dummy  , const int mode  ) {
    LAS float* tab = (LAS float*)(lds + AUX_OFF);
    for (int e = tid; e < 129 * 16; e += NWAVES * 64) tab[e] = rel_bias[t5_bucket(e >> 4) * 16 + (e & 15)];
    __syncthreads();
    LAS unsigned char* buf = lds + RING_OFF + wave * 16384;
    LAS int* idl = (LAS int*)(lds + AUX_OFF + 8448) + wave * 256;
    const int h = lane & 15, kqo = lane >> 4;
    const int qstep = G * NWAVES;
    int q = bid * NWAVES + wave;
    bf16x8 qa[8]; v4i ivn = (v4i){0, 0, 0, 0};
#pragma unroll
    for (int s = 0; s < 8; ++s) qa[s] = (bf16x8){0, 0, 0, 0, 0, 0, 0, 0};
    if (q < M) {
#pragma unroll
        for (int s = 0; s < 8; ++s) qa[s] = *(const bf16x8*)(QI + (size_t)q * NQI + h * 256 + 32 * s + 8 * kqo);
        ivn = __builtin_nontemporal_load((const v4i*)(IDX + (size_t)q * TOPK) + lane);
    }
    for (; q < M; q += qstep) {
        const int b = q >> 12, t = q & (SEQ - 1);
        const int nvalid = t + 1 < TOPK ? t + 1 : TOPK, nch = (nvalid + 31) >> 5;
        bf16* qrow = QI + (size_t)q * NQI;
        ((LAS v4i*)idl)[lane] = ivn;
        if (q + qstep < M) ivn = __builtin_nontemporal_load((const v4i*)(IDX + (size_t)(q + qstep) * TOPK) + lane);
        const bf16* ckvb = CKV + (size_t)b * SEQ * KVR;
        float m_run = -1e30f, l_part = 0.f;
        f32x4 o[16];
#pragma unroll
        for (int c = 0; c < 16; ++c) o[c] = (f32x4){0.f, 0.f, 0.f, 0.f};
#define SP_OFF(rv, j_) (((unsigned)(rv) << 9) + 16u * (unsigned)(l31_ ^ (((j_) & 7) << 1)))
#define SP_GATHER(ch_) do { int ln_ = lane; asm volatile("" : "+v"(ln_)); const int l31_ = ln_ & 31, lhi_ = ln_ >> 5; \
            const LAS v4i* il_ = (const LAS v4i*)(idl + (ch_) * 32 + 16 * lhi_); const v4i r0 = il_[0], r1 = il_[1], r2 = il_[2], r3 = il_[3]; unsigned keep_; \
            const unsigned o0 = SP_OFF(r0[0], 0), o1 = SP_OFF(r0[1], 1), o2 = SP_OFF(r0[2], 2), o3 = SP_OFF(r0[3], 3), o4 = SP_OFF(r1[0], 4), o5 = SP_OFF(r1[1], 5), o6 = SP_OFF(r1[2], 6), o7 = SP_OFF(r1[3], 7), \
                           o8 = SP_OFF(r2[0], 8), o9 = SP_OFF(r2[1], 9), o10 = SP_OFF(r2[2], 10), o11 = SP_OFF(r2[3], 11), o12 = SP_OFF(r3[0], 12), o13 = SP_OFF(r3[1], 13), o14 = SP_OFF(r3[2], 14), o15 = SP_OFF(r3[3], 15); \
            asm volatile("s_mov_b32 %0, m0\n\ts_mov_b32 m0, %1\n\ts_nop 0\n\t" \
                         "global_load_lds_dwordx4 %3, %2\n\ts_add_u32 m0, m0, 0x400\n\ts_nop 0\n\tglobal_load_lds_dwordx4 %4, %2\n\ts_add_u32 m0, m0, 0x400\n\ts_nop 0\n\t" \
                         "global_load_lds_dwordx4 %5, %2\n\ts_add_u32 m0, m0, 0x400\n\ts_nop 0\n\tglobal_load_lds_dwordx4 %6, %2\n\ts_add_u32 m0, m0, 0x400\n\ts_nop 0\n\t" \
                         "global_load_lds_dwordx4 %7, %2\n\ts_add_u32 m0, m0, 0x400\n\ts_nop 0\n\tglobal_load_lds_dwordx4 %8, %2\n\ts_add_u32 m0, m0, 0x400\n\ts_nop 0\n\t" \
                         "global_load_lds_dwordx4 %9, %2\n\ts_add_u32 m0, m0, 0x400\n\ts_nop 0\n\tglobal_load_lds_dwordx4 %10, %2\n\ts_add_u32 m0, m0, 0x400\n\ts_nop 0\n\t" \
                         "global_load_lds_dwordx4 %11, %2\n\ts_add_u32 m0, m0, 0x400\n\ts_nop 0\n\tglobal_load_lds_dwordx4 %12, %2\n\ts_add_u32 m0, m0, 0x400\n\ts_nop 0\n\t" \
                         "global_load_lds_dwordx4 %13, %2\n\ts_add_u32 m0, m0, 0x400\n\ts_nop 0\n\tglobal_load_lds_dwordx4 %14, %2\n\ts_add_u32 m0, m0, 0x400\n\ts_nop 0\n\t" \
                         "global_load_lds_dwordx4 %15, %2\n\ts_add_u32 m0, m0, 0x400\n\ts_nop 0\n\tglobal_load_lds_dwordx4 %16, %2\n\ts_add_u32 m0, m0, 0x400\n\ts_nop 0\n\t" \
                         "global_load_lds_dwordx4 %17, %2\n\ts_add_u32 m0, m0, 0x400\n\ts_nop 0\n\tglobal_load_lds_dwordx4 %18, %2\n\t" \
                         "s_mov_b32 m0, %0" \
                         : "=&s"(keep_) : "s"((unsigned)(size_t)buf), "s"(ckvb), "v"(o0), "v"(o1), "v"(o2), "v"(o3), "v"(o4), "v"(o5), "v"(o6), "v"(o7), "v"(o8), "v"(o9), "v"(o10), "v"(o11), "v"(o12), "v"(o13), "v"(o14), "v"(o15) \
                         : "memory", "scc"); } while (0)
        SP_GATHER(0);
        for (int ch = 0; ch < nch; ++ch) {
            int ln = lane; asm volatile("" : "+v"(ln) :: "memory");
            const int kq = ln >> 4, qq = (ln & 15) >> 2, p = ln & 3, xk = (ln & 7) << 1, key0 = 4 * kq + qq, k7 = key0 & 7, l15 = ln & 15;
            const v4i ki0 = *(const LAS v4i*)(idl + ch * 32 + 4 * kq), ki1 = *(const LAS v4i*)(idl + ch * 32 + 16 + 4 * kq);
            asm volatile("s_waitcnt vmcnt(0)" ::: "memory");
            bf16x8 Ar[2][8];
#pragma unroll
            for (int s = 0; s < 8; ++s) { const LAS unsigned char* ra = buf + l15 * 1024 + 16 * ((4 * s + kq) ^ xk); Ar[0][s] = *(const LAS bf16x8*)ra; Ar[1][s] = *(const LAS bf16x8*)(ra + 512); }
            __builtin_amdgcn_sched_barrier(0);
            f32x4 sa[2];
#pragma unroll
            for (int tt = 0; tt < 2; ++tt) {
                f32x4 acc = (f32x4){0.f, 0.f, 0.f, 0.f};
#pragma unroll
                for (int s = 0; s < 8; ++s) acc = __builtin_amdgcn_mfma_f32_16x16x32_bf16(Ar[tt][s], qa[s], acc, 0, 0, 0);
                sa[tt] = acc;
            }
            if (ch == nch - 1 && q + qstep < M) {
#pragma unroll
                for (int s = 0; s < 8; ++s) qa[s] = *(const bf16x8*)(QI + (size_t)(q + qstep) * NQI + h * 256 + 32 * s + 8 * kqo);
            }
            s16x4 vlo[16], vhi[16];
#pragma unroll
            for (int c = 0; c < 16; ++c) { const LAS unsigned char* a0 = buf + key0 * 1024 + 32 * (c ^ k7) + 8 * p; vlo[c] = tr_read(a0); vhi[c] = tr_read(a0 + 512); }
            __builtin_amdgcn_sched_barrier(0);
            float lg[8]; float mx = -__builtin_inff();
#pragma unroll
            for (int e = 0; e < 4; ++e) {
                const int d0 = t - ki0[e], d1 = t - ki1[e];
                lg[e] = sa[0][e] + tab[(d0 < 128 ? d0 : 128) * 16 + h]; lg[4 + e] = sa[1][e] + tab[(d1 < 128 ? d1 : 128) * 16 + h];
            }
            if (ch * 32 + 32 > nvalid) {
#pragma unroll
                for (int e = 0; e < 4; ++e) { if (ch * 32 + 4 * kq + e >= nvalid) lg[e] = -__builtin_inff(); if (ch * 32 + 16 + 4 * kq + e >= nvalid) lg[4 + e] = -__builtin_inff(); }
            }
            __builtin_amdgcn_sched_barrier(0);
            asm volatile("s_waitcnt lgkmcnt(0)" ::: "memory");
            if (ch + 1 < nch) SP_GATHER(ch + 1);
            __builtin_amdgcn_sched_barrier(0);
#pragma unroll
            for (int e = 0; e < 8; ++e) mx = fmaxf(mx, lg[e]);
            mx = xor16_max(mx); mx = xor32_max(mx);
            if (!__all(mx - m_run <= 8.0f)) {
                const float mn = fmaxf(m_run, mx), alpha = __expf(m_run - mn);
                l_part *= alpha; m_run = mn;
#pragma unroll
                for (int c = 0; c < 16; ++c) o[c] = o[c] * alpha;
            }
            float pe[8], ps = 0.f;
#pragma unroll
            for (int e = 0; e < 8; ++e) { pe[e] = __expf(lg[e] - m_run); ps += pe[e]; }
            l_part += ps;
            v4u pw; pw.x = cvtpk(pe[0], pe[1]); pw.y = cvtpk(pe[2], pe[3]); pw.z = cvtpk(pe[4], pe[5]); asm volatile("v_cvt_pk_bf16_f32 %0, %1, %2\n\ts_nop 1" : "=v"(pw.w) : "v"(pe[6]), "v"(pe[7]));
            const bf16x8 P = __builtin_bit_cast(bf16x8, pw);
#pragma unroll
            for (int c = 0; c < 16; ++c) {
                const bf16x8 A = (bf16x8){vlo[c][0], vlo[c][1], vlo[c][2], vlo[c][3], vhi[c][0], vhi[c][1], vhi[c][2], vhi[c][3]};
                o[c] = __builtin_amdgcn_mfma_f32_16x16x32_bf16(A, P, o[c], 0, 0, 0);
            }
        }
#undef SP_GATHER
#undef SP_OFF
        float l = l_part; l = xor16_sum(l); l = xor32_sum(l);
        const float inv = 1.0f / l;
        float mx = 0.f;
#pragma unroll
        for (int c = 0; c < 16; ++c) { o[c] = o[c] * inv; mx = fmaxf(mx, fmaxf(fmaxf(fabsf(o[c][0]), fabsf(o[c][1])), fmaxf(fabsf(o[c][2]), fabsf(o[c][3])))); }
#pragma unroll
        for (int s = 1; s < 16; s <<= 1) mx = fmaxf(mx, __shfl_xor(mx, s));
        mx = xor16_max(mx); mx = xor32_max(mx);
        const float qs = mx > 0.f ? 127.0f / mx : 0.f;
#pragma unroll
        for (int c = 0; c < 16; ++c) {
            const f32x4 v = o[c] * qs;
            const unsigned w = (unsigned)((int)__builtin_rintf(v[0]) & 255) | ((unsigned)((int)__builtin_rintf(v[1]) & 255) << 8) | ((unsigned)((int)__builtin_rintf(v[2]) & 255) << 16) | ((unsigned)(int)__builtin_rintf(v[3]) << 24);
            *(LAS unsigned*)(buf + h * 256 + 16 * (c ^ h) + 4 * kqo) = w; }
        asm volatile("s_waitcnt lgkmcnt(0)" ::: "memory");
        { const int hr = lane >> 2, c0 = 4 * (lane & 3);
          unsigned char* orow = (dummy ? (unsigned char*)dummy + (size_t)(q & 16383) * 8192 : (unsigned char*)qrow) + 64 * lane;
#pragma unroll
          for (int i = 0; i < 4; ++i) { const v4u w = *(const LAS v4u*)(buf + hr * 256 + 16 * ((c0 + i) ^ hr)); *(v4u*)(orow + 16 * i) = w; } }
        if (lane == 0) RSU[q] = mx * (1.0f / 127.0f);
        asm volatile("s_waitcnt lgkmcnt(0)" ::: "memory");
    }
}

__device__ __forceinline__ void cumsum_phase(const float* LF, float* CB, LAS float* wsum  , int G, int bid, int wave, int lane) {
    for (int sq = bid; sq < BATCH * NH; sq += G) {
        const int b = sq >> 4, hh = sq & 15, s0 = wave * 512 + lane * 8;
        const float* src = LF + ((size_t)b * SEQ + s0) * 16 + hh;
        float v[8];
#pragma unroll
        for (int i = 0; i < 8; ++i) v[i] = src[(size_t)i * 16];
#pragma unroll
        for (int i = 1; i < 8; ++i) v[i] += v[i - 1];
        float inc = v[7];
#pragma unroll
        for (int o = 1; o < 64; o <<= 1) { const float n = __shfl_up(inc, o); if (lane >= o) inc += n; }
        if (lane == 63) wsum[wave] = inc;
        __syncthreads();
        float pre = 0.f;
        for (int w = 0; w < wave; ++w) pre += wsum[w];
        const float off = pre + (inc - v[7]);
        float* dst = CB + (size_t)sq * SEQ + s0;
        f32x4 o0, o1;
#pragma unroll
        for (int i = 0; i < 4; ++i) { o0[i] = __int_as_float((int)__builtin_rintf(-(off + v[i]) * (11.313708498984761f * 256.0f))); o1[i] = __int_as_float((int)__builtin_rintf(-(off + v[4 + i]) * (11.313708498984761f * 256.0f))); }
        *(f32x4*)dst = o0; *(f32x4*)(dst + 4) = o1;
        __syncthreads();
    }
}

struct Args { const float* in[15]; float* out; unsigned char* ws; int ph_lo, ph_hi; };
constexpr int PH_PRO = 0, PH_PRO2 = 1, PH_L0 = 2, PH_PER_LAYER = 12, PH_FINAL = PH_L0 + 2 * PH_PER_LAYER, PH_COUNT = PH_FINAL + 1;
#define KAS __attribute__((address_space(4)))
__device__ __forceinline__ int lane_id() { int l; asm volatile("v_mbcnt_lo_u32_b32 %0, -1, 0\n\tv_mbcnt_hi_u32_b32 %0, -1, %0" : "=v"(l)); return l; }
__device__ __forceinline__ bool ph_in(int k, int lo, int hi) { asm volatile("" : "+s"(lo), "+s"(hi)); return lo <= k && k < hi; }
__global__ void __launch_bounds__(NWAVES * 64, 2) trunk_fwd(Args args) {
    extern __shared__ __attribute__((aligned(16))) unsigned char lds_raw[];
    LAS unsigned char* lds = (LAS unsigned char*)lds_raw;
    const int wave0 = __builtin_amdgcn_readfirstlane((int)threadIdx.x >> 6);
    { const int tid = threadIdx.x;
      for (int u = tid; u < (LDS_BYTES - LDSCTL_OFF) / 4; u += NWAVES * 64) ((LAS unsigned*)(lds + LDSCTL_OFF))[u] = 0u; }
    __syncthreads();
    if (!MK_SPLIT) (void)xcd_barrier_post((unsigned*)((gu32*)(args.ws + WS_CTL) + CW_BAR), (volatile LAS unsigned*)(lds + MISC_OFF) + 8, threadIdx.x == 0);
#ifndef PH_MASK
#define PH_MASK 0xFFFFFFFFu
#endif
#ifndef PROBE_DUP
#define PROBE_DUP (-1)
#endif
#define REPS(k) ((PROBE_DUP) == (k) ? 2 : 1)
#ifndef PROBE_MODE
#define PROBE_MODE 3
#endif
#define PH_EN(k) (((PH_MASK) >> ((k) == PH_PRO ? 0 : (k) == PH_PRO2 ? 14 : (k) == PH_FINAL ? 13 : 1 + (((k) - PH_L0) % PH_PER_LAYER))) & 1u)
#define IN(k) (PH_EN(k) && ph_in((k), ((const KAS Args*)__builtin_amdgcn_kernarg_segment_ptr())->ph_lo, ((const KAS Args*)__builtin_amdgcn_kernarg_segment_ptr())->ph_hi))
#define PHASE_IDS() const KAS Args* ka = (const KAS Args*)__builtin_amdgcn_kernarg_segment_ptr(); asm volatile("" : "+s"(ka)); \
    int pwave = wave0; asm volatile("" : "+s"(pwave)); int plane = lane_id(); asm volatile("" : "+v"(plane)); int pbid = blockIdx.x; asm volatile("" : "+s"(pbid)); \
    const int ptid = pwave * 64 + plane, G = gridDim.x, NGW = G * NWAVES, pgw = pbid * NWAVES + pwave; unsigned char* const ws = ka->ws; float* const out = ka->out; \
    bf16* const XN = (bf16*)(ws + WS_XN); bf16* const GATE = (bf16*)(ws + WS_GATE); bf16* const R = (bf16*)out; (void)ptid; (void)NGW; (void)pgw; (void)XN; (void)GATE; (void)out; (void)R
#define SEAM(k) do { if (IN((k) + 1)) { XcdBarrier b2; b2.bar = (unsigned*)((gu32*)(ws + WS_CTL) + CW_BAR); b2.x = xb_xcc_id(); b2.st = (volatile LAS unsigned*)(lds + MISC_OFF) + 8; xcd_barrier(b2, ptid == 0); } } while (0)

    if (IN(PH_PRO)) {
        PHASE_IDS(); const int gw = pgw, lane = plane;
        _Pragma("unroll") for (int rep = 0; rep < REPS(13); ++rep) {
        LAS float* scr = (LAS float*)(lds + RING_OFF + pwave * 16384);
        constexpr int I1 = 32 * 32, I2 = 32 * 64, I3 = 8 * 32, I4 = 32 * 64, I5 = 32 * 192, I6 = 32 * 64, I7 = 32 * 8, I8 = 32 * 64, IPL = I1 + I2 + I3 + I4 + I5 + I6 + I7 + I8;
        for (int it = gw; it < 2 * IPL; it += NGW) {
            const int j = it / IPL; int r = it - j * IPL;
            unsigned char* wb = ws + WS_W + (size_t)j * W_LAYER;
            if (r < I1) { tr_item(ka->in[4] + (size_t)j * DM * A_IN, DM, A_IN, 0, 848, (bf16*)(wb + WO_A_IN), 0, 32, scr, r, lane, ka->in[1] + (size_t)(2 * j) * DM); continue; } r -= I1;
            if (r < I2) { colmax_item(ka->in[4] + (size_t)j * DM * A_IN, A_IN, 848, A_IN, (unsigned*)(ws + WS_CMAX + 131072) + (size_t)j * DI, 0, 64, r, lane, ka->in[1] + (size_t)(2 * j) * DM); continue; } r -= I2;
            if (r < I3) { tr_item(ka->in[10] + (size_t)j * QR * 1024, QR, 1024, 0, 1024, (bf16*)(wb + WO_A_Q), 4096, 32, scr, r, lane, ka->in[5] + (size_t)j * QR); continue; } r -= I3;
            if (r < I4) { colmax_item(ka->in[11] + (size_t)j * DI * DM, DM, 0, DM, (unsigned*)(ws + WS_CMAX + 147456) + (size_t)j * DM, 0, 64, r, lane, nullptr); continue; } r -= I4;
            unsigned* cmx = (unsigned*)(ws + WS_CMAX) + (size_t)j * NB_IN;
            if (r < I5) { colmax_item(ka->in[12] + (size_t)j * DM * B_IN, B_IN, 0, 6144, cmx, 0, 192, r, lane, ka->in[1] + (size_t)(2 * j + 1) * DM); continue; } r -= I5;
            if (r < I6) { colmax_item(ka->in[12] + (size_t)j * DM * B_IN, B_IN, 6160, B_IN, cmx, 6144, 64, r, lane, ka->in[1] + (size_t)(2 * j + 1) * DM); continue; } r -= I6;
            if (r < I7) { colmax_item(ka->in[12] + (size_t)j * DM * B_IN, B_IN, 6144, 6160, cmx, 8192, 8, r, lane, ka->in[1] + (size_t)(2 * j + 1) * DM); continue; } r -= I7;
            colmax_item(ka->in[14] + (size_t)j * DI * DM, DM, 0, DM, (unsigned*)(ws + WS_CMAX + 163840) + (size_t)j * DM, 0, 64, r, lane, nullptr);
        }
        for (int it = gw; it < 2 * 16 * 16 * 8; it += NGW) {
            const int j = it >> 11, hh = (it >> 7) & 15, rt = (it >> 3) & 15, cs = it & 7, l15 = lane & 15, kq = lane >> 4;
            const float* uk = ka->in[8] + (size_t)j * KVR * DI + (size_t)(rt * 16 + l15) * DI + hh * 128 + 8 * kq;
            const float* qu = ka->in[7] + (size_t)j * QR * DI + (size_t)(cs * 64 + l15) * DI + hh * 128 + 8 * kq;
            bf16x8 af[4];
#pragma unroll
            for (int s = 0; s < 4; ++s) { const f32x4 x0 = *(const GAS f32x4*)(uk + 32 * s), x1 = *(const GAS f32x4*)(uk + 32 * s + 4);
                v4u w; w.x = pk2(x0.x, x0.y); w.y = pk2(x0.z, x0.w); w.z = pk2(x1.x, x1.y); w.w = pk2(x1.z, x1.w); af[s] = __builtin_bit_cast(bf16x8, w); }
            bf16* wt = (bf16*)(ws + WS_W + (size_t)j * W_LAYER + WO_A_Q) + (size_t)(hh * 256 + rt * 16 + 4 * kq) * QR + cs * 64 + l15;
#pragma unroll
            for (int ct = 0; ct < 4; ++ct) {
                f32x4 acc = (f32x4){0.f, 0.f, 0.f, 0.f};
                const float gq = ka->in[5][(size_t)j * QR + cs * 64 + ct * 16 + l15];
#pragma unroll
                for (int s = 0; s < 4; ++s) { const float* qp = qu + (size_t)ct * 16 * DI + 32 * s; const f32x4 x0 = *(const GAS f32x4*)qp * gq, x1 = *(const GAS f32x4*)(qp + 4) * gq;
                    v4u w; w.x = pk2(x0.x, x0.y); w.y = pk2(x0.z, x0.w); w.z = pk2(x1.x, x1.y); w.w = pk2(x1.z, x1.w);
                    acc = __builtin_amdgcn_mfma_f32_16x16x32_bf16(af[s], __builtin_bit_cast(bf16x8, w), acc, 0, 0, 0); }
#pragma unroll
                for (int e = 0; e < 4; ++e) wt[(size_t)e * QR + ct * 16] = (bf16)f2bf(acc[e] * 0.08838834764831845f);
            }
        }
        for (int it = gw; it < 2 * 2048; it += NGW) {
            const int j = it >> 11, ng = it & 2047, n = ng & 255, hh = 2 * (ng >> 8) + (n >> 7), d = n & 127;
            const float* src = ka->in[9] + (size_t)j * KVR * DI + (size_t)(4 * lane) * DI + hh * 128 + d;
            const float w0 = src[0], w1 = src[DI], w2 = src[2 * DI], w3 = src[3 * DI];
            float mx = fmaxf(fmaxf(fabsf(w0), fabsf(w1)), fmaxf(fabsf(w2), fabsf(w3)));
#pragma unroll
            for (int s = 1; s < 64; s <<= 1) mx = fmaxf(mx, __shfl_xor(mx, s));
            const float qs = mx > 0.f ? 127.0f / mx : 0.f;
            unsigned char* row = ws + WS_W + (size_t)j * W_LAYER + WO_A_UV + (size_t)ng * 512;
            const unsigned wq = (unsigned)((int)__builtin_rintf(w0 * qs) & 255) | ((unsigned)((int)__builtin_rintf(w1 * qs) & 255) << 8) | ((unsigned)((int)__builtin_rintf(w2 * qs) & 255) << 16) | ((unsigned)(int)__builtin_rintf(w3 * qs) << 24);
            *(unsigned*)(row + (n >> 7) * 256 + 4 * lane) = wq; *(unsigned*)(row + ((n >> 7) ^ 1) * 256 + 4 * lane) = 0u;
            if (lane == 0) ((float*)(ws + WS_CSC + 180224))[(size_t)j * DI + ng] = mx * (1.0f / 127.0f);
        }
        for (int m = gw; m < M; m += NGW) { const float s = row_to_bf16_ss(ka->in[0] + (size_t)m * DM, R + (size_t)m * DM, ws + WS_H8 + (size_t)m * DM, lane); if (lane < 8) ((float*)(ws + WS_SS))[(size_t)m * 8 + lane] = lane == 0 ? s : 0.f; }
        }
        SEAM(PH_PRO);
    }
    if (IN(PH_PRO2)) {
        PHASE_IDS(); const int gw = pgw, lane = plane;
        LAS float* scr = (LAS float*)(lds + RING_OFF + pwave * 16384);
        constexpr int I2 = 32 * 64, I5 = 32 * 192, I6 = 32 * 64, I7 = 32 * 8, I4 = 32 * 64, I8 = 32 * 64, IPL = I2 + I5 + I6 + I7 + I4 + I8;
        for (int it = gw; it < 2 * IPL; it += NGW) {
            const int j = it / IPL; int r = it - j * IPL;
            if (r < I2) { tr_item_i8(ka->in[4] + (size_t)j * DM * A_IN, DM, A_IN, 848, A_IN, ws + WS_W + (size_t)j * W_LAYER + WO_A_IN + 4 * MiB, 0, 64, scr, r, lane, ka->in[1] + (size_t)(2 * j) * DM,
                                      (const unsigned*)(ws + WS_CMAX + 131072) + (size_t)j * DI, (float*)(ws + WS_CSC + 131072) + (size_t)j * DI, 1.0f / pg8::ACT_Q); continue; } r -= I2;
            unsigned char* wq = ws + WS_W + (size_t)j * W_LAYER + WO_B_IN; const unsigned* cmx = (const unsigned*)(ws + WS_CMAX) + (size_t)j * NB_IN; float* csc = (float*)(ws + WS_CSC) + (size_t)j * NB_IN;
            const float* W = ka->in[12] + (size_t)j * DM * B_IN; const float* gn = ka->in[1] + (size_t)(2 * j + 1) * DM;
            if (r < I5) { tr_item_i8(W, DM, B_IN, 0, 6144, wq, 0, 192, scr, r, lane, gn, cmx, csc, 1.0f / pg8::ACT_Q); continue; } r -= I5;
            if (r < I6) { tr_item_i8(W, DM, B_IN, 6160, B_IN, wq, 6144, 64, scr, r, lane, gn, cmx, csc, 1.0f / pg8::ACT_Q); continue; } r -= I6;
            if (r < I7) { tr_item_i8(W, DM, B_IN, 6144, 6160, wq, 8192, 8, scr, r, lane, gn, cmx, csc, 1.0f / pg8::ACT_Q); continue; } r -= I7;
            if (r < I4) { tr_item_i8(ka->in[11] + (size_t)j * DI * DM, DI, DM, 0, DM, ws + WS_W + (size_t)j * W_LAYER + WO_A_OUT, 0, 64, scr, r, lane, nullptr, (const unsigned*)(ws + WS_CMAX + 147456) + (size_t)j * DM, (float*)(ws + WS_CSC + 147456) + (size_t)j * DM, 1.0f); continue; } r -= I4;
            tr_item_i8(ka->in[14] + (size_t)j * DI * DM, DI, DM, 0, DM, ws + WS_W + (size_t)j * W_LAYER + WO_B_OUT, 0, 64, scr, r, lane, nullptr, (const unsigned*)(ws + WS_CMAX + 163840) + (size_t)j * DM, (float*)(ws + WS_CSC + 163840) + (size_t)j * DM, 1.0f);
        }
        SEAM(PH_PRO2);
#if defined(PROBE_XBAR)
        _Pragma("unroll") for (int xb = 0; xb < 16; ++xb) { SEAM(PH_PRO2); }
#endif
    }

    for (int j = 0; j < 2; ++j) {
        const int P = PH_L0 + j * PH_PER_LAYER;
        const size_t wbo = WS_W + (size_t)j * W_LAYER;
        if (IN(P + 0)) {
_Pragma("unroll") for (int rep = 0; rep < REPS(0); ++rep) { PHASE_IDS();
            { pg8::Gemm g{R, (const bf16*)(ws + wbo + WO_A_IN), M, 1024, DM, DM, 0}; pg8::StaticOrder S; S.init(M, 1024, G, pbid);
              pg8::EpiAIn E{(bf16*)(ws + WS_CQ), (bf16*)(ws + WS_CKV), (float*)(ws + WS_CQRAW), ka->in[6] + (size_t)j * KVR, (bf16*)(ws + WS_IK), (float*)(ws + WS_IW), (const float*)(ws + WS_SS) + (size_t)(2 * j) * M * 8, (LAS float*)(lds + AUX_OFF)};
              pg8::gemm_phase<pg8::EpiAIn, pg8::StaticOrder, true, true>(lds + RING_OFF, g, S, E, ptid); }
            { pg8::Gemm g{(const bf16*)(ws + WS_H8), (const bf16*)(ws + wbo + WO_A_IN + 4 * MiB), M, DI, DM / 2, DM / 2, 0}; pg8::StaticOrder S; S.init(M, DI, G, pbid);
              pg8::EpiAGate E{GATE, (const float*)(ws + WS_SS) + (size_t)(2 * j) * M * 8, (const float*)(ws + WS_CSC + 131072) + (size_t)j * DI};
              pg8::gemm_phase<pg8::EpiAGate, pg8::StaticOrder, true, true, 2>(lds + RING_OFF, g, S, E, ptid); }
            }
            { PHASE_IDS(); SEAM(P + 0); }
        }
        if (IN(P + 1)) {
_Pragma("unroll") for (int rep = 0; rep < REPS(1); ++rep) { PHASE_IDS();
            pg8::Gemm g{(const bf16*)(ws + WS_CQ), (const bf16*)(ws + wbo + WO_A_Q), M, NQI, QR, QR, 0}; pg8::StaticOrder S; S.init(M, NQI, G, pbid);
            pg8::EpiQ E{(bf16*)(ws + WS_QI), NQI, (const float*)(ws + WS_CQRAW)};
            pg8::gemm_phase<pg8::EpiQ, pg8::StaticOrder, true, true>(lds + RING_OFF, g, S, E, ptid);
            }
            { PHASE_IDS(); SEAM(P + 1); }
        }
        if (IN(P + 2)) {
_Pragma("unroll") for (int rep = 0; rep < REPS(2); ++rep) { PHASE_IDS();
            topk_phase(lds, (const bf16*)(ws + WS_QI), (const bf16*)(ws + WS_IK), (const float*)(ws + WS_IW), (int*)(ws + WS_IDX), G, pbid, pwave, plane, (REPS(2) == 2 && rep == 0) ? PROBE_MODE : 3);
            }
            { PHASE_IDS(); SEAM(P + 2); }
        }
        if (IN(P + 3)) {
_Pragma("unroll") for (int rep = 0; rep < REPS(3); ++rep) { PHASE_IDS();
            sparse_phase(lds, (bf16*)(ws + WS_QI), (const bf16*)(ws + WS_CKV), (const int*)(ws + WS_IDX), ka->in[3], (float*)(ws + WS_RS), G, pbid, pwave, plane, ptid, (REPS(3) == 2 && rep == 0) ? XN : nullptr, (REPS(3) == 2 && rep == 0) ? PROBE_MODE : 3);
            }
            { PHASE_IDS(); SEAM(P + 3); }
        }
        if (IN(P + 4)) {
_Pragma("unroll") for (int rep = 0; rep < REPS(4); ++rep) { PHASE_IDS();
            pg8::Gemm g{(const bf16*)(ws + WS_QI), (const bf16*)(ws + wbo + WO_A_UV), M, DI, 256, NQI, 256}; pg8::StaticOrder S; S.init(M, DI, G, pbid);
            pg8::EpiUV E{XN, (const float*)(ws + WS_RS), (const float*)(ws + WS_CSC + 180224) + (size_t)j * DI};
            pg8::gemm_phase<pg8::EpiUV, pg8::StaticOrder, true, true, 2>(lds + RING_OFF, g, S, E, ptid);
            }
            { PHASE_IDS(); SEAM(P + 4); }
        }
        if (IN(P + 5)) {
            { PHASE_IDS();
            for (int m = pgw; m < M; m += NGW) requant_row_gate(XN + (size_t)m * DM, (const unsigned char*)GATE + (size_t)m * DM, (float*)(ws + WS_RS) + m, plane);
            }
            { PHASE_IDS(); SEAM(P + 5); }
        }
        if (IN(P + 6)) {
{ PHASE_IDS();
            pg8::Gemm g{XN, (const bf16*)(ws + wbo + WO_A_OUT), M, DM, DI / 2, DI, 0}; pg8::StaticOrder S; S.init(M, DM, G, pbid);
            if (j == 0) { pg8::EpiRes<true> E{ka->in[0], (bf16*)nullptr, R, (unsigned char*)GATE, (float*)(ws + WS_SS) + (size_t)(2 * j + 1) * M * 8, (LAS float*)(lds + AUX_OFF), (const float*)(ws + WS_RS), (const float*)(ws + WS_CSC + 147456) + (size_t)j * DM};
              pg8::gemm_phase<pg8::EpiRes<true>, pg8::StaticOrder, true, true, 2>(lds + RING_OFF, g, S, E, ptid); }
            else { pg8::EpiRes<false> E{(const float*)nullptr, (bf16*)nullptr, R, (unsigned char*)GATE, (float*)(ws + WS_SS) + (size_t)(2 * j + 1) * M * 8, (LAS float*)(lds + AUX_OFF), (const float*)(ws + WS_RS), (const float*)(ws + WS_CSC + 147456) + (size_t)j * DM};
              pg8::gemm_phase<pg8::EpiRes<false>, pg8::StaticOrder, true, true, 2>(lds + RING_OFF, g, S, E, ptid); }
            }
            { PHASE_IDS(); SEAM(P + 6); }
        }
        if (IN(P + 7)) {
            { PHASE_IDS();
              LAS unsigned char* wl = (LAS unsigned char*)(lds + RING_OFF);
              fpre_stage(wl, ws + wbo + WO_B_IN + (size_t)8192 * 2048, ptid);
              bool first = true;
              for (int r0 = pgw * 16; r0 < M; r0 += NGW * 16, first = false)
                  fpre_rows(wl, (const unsigned char*)GATE, (const float*)(ws + WS_SS) + (size_t)(2 * j + 1) * M * 8, (const float*)(ws + WS_CSC) + (size_t)j * NB_IN + 8192, ka->in[13] + (size_t)j * NH, (float*)(ws + WS_LF), r0, plane, first);
              __syncthreads(); }
_Pragma("unroll") for (int rep = 0; rep < REPS(7); ++rep) { PHASE_IDS();
            pg8::Gemm g{GATE, (const bf16*)(ws + wbo + WO_B_IN), M, 8192, DM / 2, DM / 2, 0}; pg8::StaticOrder S; S.init(M, 8192, G, pbid);
            pg8::EpiBIn E{(bf16*)(ws + WS_Q), (size_t)(WS_K - WS_Q) / 2, XN, (float*)(ws + WS_LF), ka->in[13] + (size_t)j * NH, (const float*)(ws + WS_SS) + (size_t)(2 * j + 1) * M * 8, (const float*)(ws + WS_CSC) + (size_t)j * NB_IN};
            pg8::gemm_phase<pg8::EpiBIn, pg8::StaticOrder, true, true, 2>(lds + RING_OFF, g, S, E, ptid);
            }
            { PHASE_IDS(); SEAM(P + 7); }
        }
        if (IN(P + 8)) {
_Pragma("unroll") for (int rep = 0; rep < REPS(8); ++rep) { PHASE_IDS();
            cumsum_phase((const float*)(ws + WS_LF), (float*)(ws + WS_CB), (LAS float*)(lds + AUX_OFF), G, pbid, pwave, plane);
            }
            { PHASE_IDS(); SEAM(P + 8); }
        }
        if (IN(P + 9)) {
_Pragma("unroll") for (int rep = 0; rep < REPS(9); ++rep) { PHASE_IDS();
            const fox::Tensors T{ws + WS_Q, ws + WS_K, (const fox::bf16*)(ws + WS_V), (fox::bf16*)GATE, (const unsigned char*)XN, (const float*)(ws + WS_CB), (float*)(ws + WS_RMP)};
            fox::attn_phase((char*)lds_raw + RING_OFF, T, G, pbid, ptid);
            }
            { PHASE_IDS(); SEAM(P + 9); }
        }
        if (IN(P + 10)) {
            { PHASE_IDS();
            for (int m = pgw; m < M; m += NGW) requant_row_gate(GATE + (size_t)m * DM, (const unsigned char*)XN + (size_t)m * DM, (float*)(ws + WS_RS) + m, plane);
            }
            { PHASE_IDS(); SEAM(P + 10); }
        }
        if (IN(P + 11)) {
            { PHASE_IDS();
            pg8::Gemm g{GATE, (const bf16*)(ws + wbo + WO_B_OUT), M, DM, DI / 2, DI, 0}; pg8::StaticOrder S; S.init(M, DM, G, pbid);
            pg8::EpiRes<false> E{(const float*)nullptr, j == 1 ? (bf16*)(ws + WS_R) : (bf16*)nullptr, R, j == 0 ? ws + WS_H8 : (unsigned char*)nullptr, (float*)(ws + WS_SS) + (size_t)(j == 0 ? 2 : 0) * M * 8,     (LAS float*)(lds + AUX_OFF), (const float*)(ws + WS_RS), (const float*)(ws + WS_CSC + 163840) + (size_t)j * DM};
            pg8::gemm_phase<pg8::EpiRes<false>, pg8::StaticOrder, true, true, 2>(lds + RING_OFF, g, S, E, ptid);
            }
            { PHASE_IDS(); SEAM(P + 11); }
        }
    }
    if (IN(PH_FINAL)) {
        PHASE_IDS();
        for (int m = pgw; m < M; m += NGW) rms_row_final((const bf16*)(ws + WS_R) + (size_t)m * DM, (const float*)(ws + WS_SS) + (size_t)m * 8, out + (size_t)m * DM, ka->in[2], plane);
    }
#undef IN
#undef SEAM
}

extern "C" void kernel_launch(void* const* d_in, const int* in_sizes, int n_in, void* d_out, int out_size, void* d_ws, size_t ws_size, hipStream_t stream) {
    static int grid = 0;
    if (grid == 0) {
        if (n_in != 15 || in_sizes[0] != M * DM || out_size != M * DM || ws_size < WS_END) {
            fprintf(stderr, "kernel_launch: shape/workspace mismatch (n_in %d, in0 %d, out %d, ws %zu, need %zu); nothing launched\n", n_in, n_in > 0 ? in_sizes[0] : -1, out_size, ws_size, (size_t)WS_END); grid = -1; return; }
        int dev = 0, cus = 0, per_cu = 0;
        if (hipGetDevice(&dev) != hipSuccess || hipDeviceGetAttribute(&cus, hipDeviceAttributeMultiprocessorCount, dev) != hipSuccess) { grid = -1; return; }
        if (hipFuncSetAttribute((const void*)trunk_fwd, hipFuncAttributeMaxDynamicSharedMemorySize, LDS_BYTES) != hipSuccess) { fprintf(stderr, "kernel_launch: hipFuncSetAttribute failed\n"); grid = -1; return; }
        if (hipOccupancyMaxActiveBlocksPerMultiprocessor(&per_cu, (const void*)trunk_fwd, NWAVES * 64, LDS_BYTES) != hipSuccess || per_cu < 1)
            fprintf(stderr, "kernel_launch: note: occupancy query reports %d workgroups per CU\n", per_cu);
        (void)hipGetLastError();
        grid = cus;
    }
    if (grid < 0) return;
    if (hipMemsetAsync((char*)d_ws + WS_CTL, 0, CTL_ZERO_BYTES, stream) != hipSuccess) return;
    Args a{};
    for (int i = 0; i < 15; ++i) a.in[i] = (const float*)d_in[i];
    a.out = (float*)d_out; a.ws = (unsigned char*)d_ws;
#if MK_SPLIT
    for (int p = 0; p < PH_COUNT; ++p) { a.ph_lo = p; a.ph_hi = p + 1; hipLaunchKernelGGL(trunk_fwd, dim3(grid), dim3(NWAVES * 64), LDS_BYTES, stream, a); }
#else
    a.ph_lo = 0; a.ph_hi = PH_COUNT;
    hipLaunchKernelGGL(trunk_fwd, dim3(grid), dim3(NWAVES * 64), LDS_BYTES, stream, a);
#endif
    const hipError_t le = hipPeekAtLastError();
    if (le != hipSuccess) fprintf(stderr, "kernel_launch: launch failed: %s\n", hipGetErrorName(le));
}
```
